# Optimizing an MI355X kernel written in HIP

```python
import math
import jax, jax.numpy as jnp
from jax import lax
import numpy as np

D_MODEL = 1024
BATCH = 4
SEQ = 8192
DEPTH = 1

CHUNK = 64
CONV_K = 4
EPS = 1e-6
ML_HEADS = 8
ML_INNER = 2 * D_MODEL
ML_DV = ML_INNER // ML_HEADS
ML_DQK = ML_DV // 2
ML_QK2 = 2 * ML_HEADS * ML_DQK
SSM_INNER = 2 * D_MODEL
SSM_HEADDIM = 64
SSM_HEADS = SSM_INNER // SSM_HEADDIM
SSM_GROUPS = 4
SSM_STATE = 128
SSM_XBC = SSM_INNER + 2 * SSM_GROUPS * SSM_STATE
SEG_SIZES = (ML_QK2, ML_INNER, ML_INNER, ML_INNER, ML_HEADS, ML_HEADS,
             SSM_XBC, SSM_INNER, SSM_HEADS, 2 * D_MODEL)
IN_WIDTH = sum(SEG_SIZES)
SEG_SPLITS = tuple(np.cumsum(SEG_SIZES)[:-1].tolist())

kernel_name = 'hybrid_mlstm_ssd_gated_merge'


def _rmsnorm(x, w):
    xf = x.astype(jnp.float32)
    y = xf * lax.rsqrt(jnp.mean(xf * xf, axis=-1, keepdims=True) + EPS)
    return (y * w.astype(jnp.float32)).astype(x.dtype)


def _causal_dwconv(x, w, b):
    s = x.shape[1]
    k = w.shape[0]
    xp = jnp.pad(x, ((0, 0), (k - 1, 0), (0, 0)))
    y = b
    for j in range(k):
        y = y + xp[:, j:j + s, :] * w[j]
    return y


def _chunk_heads(t):
    b, s = t.shape[:2]
    t = t.reshape(b, s // CHUNK, CHUNK, *t.shape[2:])
    perm = (1, 0, 3, 2) + tuple(range(4, t.ndim))
    return jnp.transpose(t, perm)


def _mlstm(q, k, v, i_pre, f_pre):
    f32 = jnp.float32
    b, s, h, dqk = q.shape
    dv = v.shape[-1]
    qc = _chunk_heads(q.astype(f32) * (dqk ** -0.5))
    kc = _chunk_heads(k.astype(f32))
    vc = _chunk_heads(v.astype(f32))
    ic = _chunk_heads(i_pre.astype(f32))
    fc = _chunk_heads(jax.nn.log_sigmoid(f_pre.astype(f32)))
    causal = jnp.tril(jnp.ones((CHUNK, CHUNK), dtype=bool))

    def step(carry, inp):
        c_mat, n_vec, m = carry
        qb, kb, vb, ib, fb = inp
        a = jnp.cumsum(fb, axis=-1)
        dmat = jnp.where(causal, a[..., :, None] - a[..., None, :] + ib[..., None, :], -jnp.inf)
        inter = a + m[..., None]
        m_t = jnp.maximum(inter, jnp.max(dmat, axis=-1))
        w_intra = jnp.exp(dmat - m_t[..., None])
        w_inter = jnp.exp(inter - m_t)
        sc = jnp.einsum('bhld,bhsd->bhls', qb, kb) * w_intra
        num = jnp.einsum('bhls,bhsv->bhlv', sc, vb) + w_inter[..., None] * jnp.einsum('bhld,bhdv->bhlv', qb, c_mat)
        den = jnp.sum(sc, axis=-1) + w_inter * jnp.einsum('bhld,bhd->bhl', qb, n_vec)
        hb = num / jnp.maximum(jnp.abs(den), jnp.exp(-m_t))[..., None]
        a_last = a[..., -1]
        g = a_last[..., None] - a + ib
        m_new = jnp.maximum(a_last + m, jnp.max(g, axis=-1))
        wk = jnp.exp(g - m_new[..., None])
        decay = jnp.exp(a_last + m - m_new)
        c_new = decay[..., None, None] * c_mat + jnp.einsum('bhl,bhld,bhlv->bhdv', wk, kb, vb)
        n_new = decay[..., None] * n_vec + jnp.einsum('bhl,bhld->bhd', wk, kb)
        return (c_new, n_new, m_new), hb

    init = (jnp.zeros((b, h, dqk, dv), f32), jnp.zeros((b, h, dqk), f32), jnp.zeros((b, h), f32))
    _, hs = lax.scan(step, init, (qc, kc, vc, ic, fc))
    return jnp.transpose(hs, (1, 0, 3, 2, 4)).reshape(b, s, h, dv)


def _ssd(x, dt, a_coef, bm, cm):
    f32 = jnp.float32
    b, s, h, p = x.shape
    g, n = bm.shape[2:]
    hg = h // g
    nc = s // CHUNK
    xc = _chunk_heads(x.astype(f32)).reshape(nc, b, g, hg, CHUNK, p)
    dtc = _chunk_heads(dt.astype(f32)).reshape(nc, b, g, hg, CHUNK)
    bc = _chunk_heads(bm.astype(f32))
    cc = _chunk_heads(cm.astype(f32))
    a_g = a_coef.astype(f32).reshape(g, hg)
    causal = jnp.tril(jnp.ones((CHUNK, CHUNK), dtype=bool))

    def step(state, inp):
        xb, dtb, bb, cb = inp
        a = jnp.cumsum(dtb * a_g[..., None], axis=-1)
        decay = jnp.exp(jnp.where(causal, a[..., :, None] - a[..., None, :], -jnp.inf))
        scores = jnp.einsum('bgln,bgsn->bgls', cb, bb)
        mix = decay * scores[:, :, None] * dtb[..., None, :]
        y = jnp.einsum('bghls,bghsp->bghlp', mix, xb)
        y = y + jnp.exp(a)[..., None] * jnp.einsum('bgln,bghpn->bghlp', cb, state)
        a_last = a[..., -1:]
        wts = jnp.exp(a_last - a) * dtb
        state = jnp.exp(a_last)[..., None] * state + jnp.einsum('bghs,bgsn,bghsp->bghpn', wts, bb, xb)
        return state, y

    init = jnp.zeros((b, g, hg, p, n), f32)
    _, ys = lax.scan(step, init, (xc, dtc, bc, cc))
    return jnp.transpose(ys, (1, 0, 4, 2, 3, 5)).reshape(b, s, h, p)


def setup_inputs(seed: int = 0) -> dict:
    key = jax.random.key(seed)
    ks = jax.random.split(key, 24)
    f32 = jnp.float32

    def nrm(k, shape, scale):
        return jax.random.normal(k, shape, f32) * scale

    x = nrm(ks[0], (BATCH, SEQ, D_MODEL), 1.0)
    c = nrm(ks[1], (BATCH, D_MODEL), 1.0)
    norm_w = 1.0 + nrm(ks[2], (DEPTH, D_MODEL), 0.02)
    ada_w = nrm(ks[3], (DEPTH, D_MODEL, 3 * D_MODEL), 0.1 * D_MODEL ** -0.5)
    ada_b = nrm(ks[4], (DEPTH, 3 * D_MODEL), 0.02)
    w_in = nrm(ks[5], (DEPTH, D_MODEL, IN_WIDTH), D_MODEL ** -0.5)
    b_base = nrm(ks[6], (DEPTH, IN_WIDTH), 0.02)
    f_bias = jnp.linspace(3.0, 6.0, ML_HEADS, dtype=f32) + nrm(ks[7], (DEPTH, ML_HEADS), 0.1)
    dt0 = jnp.exp(jax.random.uniform(ks[8], (DEPTH, SSM_HEADS), f32, math.log(1e-3), math.log(1e-1)))
    dt_bias = dt0 + jnp.log(-jnp.expm1(-dt0))
    f_off = sum(SEG_SIZES[:5])
    dt_off = sum(SEG_SIZES[:8])
    b_in = b_base.at[:, f_off:f_off + ML_HEADS].set(f_bias).at[:, dt_off:dt_off + SSM_HEADS].set(dt_bias)
    ml_conv_w = nrm(ks[9], (DEPTH, CONV_K, ML_QK2), CONV_K ** -0.5)
    ml_conv_b = nrm(ks[10], (DEPTH, ML_QK2), 0.02)
    ml_norm_w = 1.0 + nrm(ks[11], (DEPTH, ML_INNER), 0.02)
    ssm_conv_w = nrm(ks[12], (DEPTH, CONV_K, SSM_XBC), CONV_K ** -0.5)
    ssm_conv_b = nrm(ks[13], (DEPTH, SSM_XBC), 0.02)
    ssm_a_log = jnp.log(jax.random.uniform(ks[14], (DEPTH, SSM_HEADS), f32, 1.0, 16.0))
    ssm_d = 1.0 + nrm(ks[15], (DEPTH, SSM_HEADS), 0.1)
    ssm_norm_w = 1.0 + nrm(ks[16], (DEPTH, SSM_INNER), 0.02)
    w_proj_m = nrm(ks[17], (DEPTH, ML_INNER, D_MODEL), ML_INNER ** -0.5)
    w_proj_s = nrm(ks[18], (DEPTH, SSM_INNER, D_MODEL), SSM_INNER ** -0.5)
    w_out = nrm(ks[19], (DEPTH, D_MODEL, D_MODEL), D_MODEL ** -0.5)
    final_w = 1.0 + nrm(ks[20], (D_MODEL,), 0.02)
    return {'x': x, 'c': c, 'norm_w': norm_w, 'ada_w': ada_w, 'ada_b': ada_b,
            'w_in': w_in, 'b_in': b_in, 'ml_conv_w': ml_conv_w, 'ml_conv_b': ml_conv_b,
            'ml_norm_w': ml_norm_w, 'ssm_conv_w': ssm_conv_w, 'ssm_conv_b': ssm_conv_b,
            'ssm_a_log': ssm_a_log, 'ssm_d': ssm_d, 'ssm_norm_w': ssm_norm_w,
            'w_proj_m': w_proj_m, 'w_proj_s': w_proj_s, 'w_out': w_out, 'final_w': final_w}


def reference(x, c, norm_w, ada_w, ada_b, w_in, b_in, ml_conv_w, ml_conv_b, ml_norm_w,
              ssm_conv_w, ssm_conv_b, ssm_a_log, ssm_d, ssm_norm_w, w_proj_m, w_proj_s,
              w_out, final_w):
    b, s, _ = x.shape
    for l in range(DEPTH):
        mod = jax.nn.silu(c) @ ada_w[l] + ada_b[l]
        shift, scale, gate = jnp.split(mod, 3, axis=-1)
        u = _rmsnorm(x, norm_w[l]) * (1.0 + scale[:, None, :]) + shift[:, None, :]
        proj = u @ w_in[l] + b_in[l]
        qk, v, o_pre, z_m, i_pre, f_pre, xbc, z_s, dt_raw, merge_pre = jnp.split(proj, SEG_SPLITS, axis=-1)

        qk = jax.nn.silu(_causal_dwconv(qk, ml_conv_w[l], ml_conv_b[l]))
        q, k = jnp.split(qk, 2, axis=-1)
        h_m = _mlstm(q.reshape(b, s, ML_HEADS, ML_DQK), k.reshape(b, s, ML_HEADS, ML_DQK),
                     v.reshape(b, s, ML_HEADS, ML_DV), i_pre, f_pre)
        h_m = _rmsnorm(h_m, ml_norm_w[l].reshape(ML_HEADS, ML_DV)).reshape(b, s, ML_INNER).astype(x.dtype)
        y_m = jax.nn.sigmoid(o_pre) * h_m * jax.nn.silu(z_m)

        xbc = jax.nn.silu(_causal_dwconv(xbc, ssm_conv_w[l], ssm_conv_b[l]))
        xs, bs, cs = jnp.split(xbc, (SSM_INNER, SSM_INNER + SSM_GROUPS * SSM_STATE), axis=-1)
        dt = jax.nn.softplus(dt_raw.astype(jnp.float32))
        a_coef = -jnp.exp(ssm_a_log[l].astype(jnp.float32))
        xh = xs.reshape(b, s, SSM_HEADS, SSM_HEADDIM)
        y_s = _ssd(xh, dt, a_coef, bs.reshape(b, s, SSM_GROUPS, SSM_STATE), cs.reshape(b, s, SSM_GROUPS, SSM_STATE))
        y_s = y_s + ssm_d[l][:, None] * xh
        y_s = (y_s.reshape(b, s, SSM_INNER) * jax.nn.silu(z_s)).reshape(b, s, SSM_GROUPS, SSM_INNER // SSM_GROUPS)
        y_s = _rmsnorm(y_s, ssm_norm_w[l].reshape(SSM_GROUPS, SSM_INNER // SSM_GROUPS)).reshape(b, s, SSM_INNER).astype(x.dtype)

        gate_m, gate_s = jnp.split(jax.nn.sigmoid(merge_pre), 2, axis=-1)
        merged = gate_m * (y_m @ w_proj_m[l]) + gate_s * (y_s @ w_proj_s[l])
        x = x + gate[:, None, :] * (merged @ w_out[l])
    return _rmsnorm(x, final_w)
```

```cpp
#include <hip/hip_runtime.h>
#include <hip/hip_cooperative_groups.h>
#include <cstdio>
#include <cstdint>
namespace cg = cooperative_groups;
#ifndef ONE_LAUNCH
#define ONE_LAUNCH 1
#endif
namespace pg8 {
#define PG8_LAS __attribute__((address_space(3)))
typedef unsigned short bf16_t;
typedef short bf16x8 __attribute__((ext_vector_type(8)));
typedef float f32x4 __attribute__((ext_vector_type(4)));
typedef unsigned u32x4 __attribute__((ext_vector_type(4)));
constexpr int BM = 256, BK = 64, HALF = 128, HTB = HALF * BK * 2  , STAGE_BYTES = 8 * HTB, NXCD = 8, WGM = 8;

__host__ __device__ __forceinline__ int lds_byte(int r, int c) { const int st = (r >> 4) * 2 + (c >> 5), rr = r & 15, cc = c & 31, ob = rr * 64 + cc * 2; return st * 1024 + (ob ^ (((ob >> 9) & 1) << 5)); }
__host__ __device__ __forceinline__ void stage_rc(int b, int& R, int& C) { const int st = b / 1024, sb = b % 1024, swz = sb ^ (((sb >> 9) & 1) << 5); R = (st >> 1) * 16 + swz / 64; C = (st & 1) * 32 + (swz % 64) / 2; }
__host__ __device__ __forceinline__ int perm32(int rho) { const int n = rho >> 4, i = rho & 15; return 8 * (i >> 2) + 4 * n + (i & 3); }

struct Unit { int pm, pn; };
struct Gemm { const bf16_t* A; const bf16_t* Bt; int M, N, K; };

struct StaticOrder {
    int nM, nN, nwg, G, c;
    __host__ __device__ void init(int M, int N, int G_, int c_) { nM = M / BM; nN = N / BM; nwg = nM * nN; G = G_; c = c_; }
    __host__ __device__ bool next(int i, Unit& u) const {
        const long L = (long)i * G + c; if (L >= nwg) return false;
        int wgid = (int)L; { const int q = nwg / NXCD, r = nwg % NXCD, xcd = wgid % NXCD, off = wgid / NXCD; wgid = (xcd < r ? xcd * (q + 1) : r * (q + 1) + (xcd - r) * q) + off; }
        const int nig = WGM * nN, gid = wgid / nig, fm = gid * WGM, gsz = (nM - fm) < WGM ? (nM - fm) : WGM;
        u.pm = fm + ((wgid % nig) % gsz); u.pn = (wgid % nig) / gsz; return true;
    }
    __device__ __forceinline__ void a_ready(const Unit&) const {}
    __device__ __forceinline__ void done(const Unit&) const {}
};
template <class Epi, class Sched, bool ALIGN_EPI = false, bool SP2 = false>
__device__ __forceinline__ void gemm_phase(PG8_LAS unsigned char* lds, const Gemm g, const Sched& S, const Epi& E) {
    int tid = threadIdx.x; asm volatile("" : "+v"(tid)); const int wid = __builtin_amdgcn_readfirstlane(tid >> 6), lane = tid & 63, wr = wid >> 2, wc = wid & 3, fr = lane & 15, fq = lane >> 4;
    const int K = g.K, nt = K / BK;
    unsigned voffA[2], voffB[2];
#pragma unroll
    for (int i = 0; i < 2; ++i) { int R, C; stage_rc(tid * 16 + i * 8192, R, C); const int Rb = Epi::PERM ? ((R & ~31) + perm32(R & 31)) : R;
        voffA[i] = (unsigned)(R * K + C) * 2u; voffB[i] = (unsigned)(Rb * K + C) * 2u; }
    const size_t kstep = (size_t)(BK * 2);
    const size_t hstep = (size_t)HALF * K * 2;
    const size_t tstep = 2 * hstep;
    const unsigned ldsw = (unsigned)wid * 1024u;
    const int aoff = lds_byte(wr * 64 + fr, fq * 8), boff = lds_byte(wc * 32 + fr, fq * 8);
#define PG8_SA(b, h) (((b) * 2 + (h)) * HTB)
#define PG8_SB(b, h) ((4 + (b) * 2 + (h)) * HTB)
#define PG8_STAGE(bufoff, gbase, voff) do { _Pragma("unroll") for (int _i = 0; _i < 2; ++_i) \
        __builtin_amdgcn_global_load_lds((const unsigned*)((const char*)(gbase) + (voff)[_i]), (PG8_LAS unsigned*)(lds + (bufoff) + ldsw + _i * 8192), 16, 0, 0); } while (0)
#define PG8_LDA(dst, b, h) do { _Pragma("unroll") for (int m = 0; m < 4; ++m) _Pragma("unroll") for (int k = 0; k < 2; ++k) dst[m][k] = *(const PG8_LAS bf16x8*)(lds + PG8_SA(b, h) + aoff + m * 2048 + k * 1024); } while (0)
#define PG8_LDB(dst, b, h) do { _Pragma("unroll") for (int n = 0; n < 2; ++n) _Pragma("unroll") for (int k = 0; k < 2; ++k) dst[n][k] = *(const PG8_LAS bf16x8*)(lds + PG8_SB(b, h) + boff + n * 2048 + k * 1024); } while (0)
#define PG8_MMA(ai, bj, At, Bt) do { __builtin_amdgcn_s_setprio(1); _Pragma("unroll") for (int m = 0; m < 4; ++m) _Pragma("unroll") for (int n = 0; n < 2; ++n) _Pragma("unroll") for (int k = 0; k < 2; ++k) \
        acc[ai][bj][m][n] = __builtin_amdgcn_mfma_f32_16x16x32_bf16(Bt[n][k], At[m][k], acc[ai][bj][m][n], 0, 0, 0); __builtin_amdgcn_s_setprio(0); } while (0)
#define PG8_WAIT_V(n) asm volatile("s_waitcnt vmcnt(" #n ")" ::: "memory")
#define PG8_WAIT_L(n) asm volatile("s_waitcnt lgkmcnt(" #n ")" ::: "memory")
#define PG8_BAR __builtin_amdgcn_s_barrier()
#define PG8_SCHED __builtin_amdgcn_sched_barrier(0)
    Unit cur, nxt; int ui = 0;
    if (!S.next(0, cur)) return;
    f32x4 acc[2][2][4][2];
#pragma unroll
    for (int a = 0; a < 2; ++a)
#pragma unroll
        for (int b = 0; b < 2; ++b)
#pragma unroll
            for (int m = 0; m < 4; ++m)
#pragma unroll
                for (int n = 0; n < 2; ++n) acc[a][b][m][n] = (f32x4){0.f, 0.f, 0.f, 0.f};
    bf16x8 At[4][2], B0[2][2], B1[2][2];
    const char* cA = (const char*)g.A + (size_t)cur.pm * tstep; const char* cB = (const char*)g.Bt + (size_t)cur.pn * tstep;
    S.a_ready(cur);
    if constexpr (SP2) {
        PG8_STAGE(PG8_SB(0, 0), cB, voffB); PG8_STAGE(PG8_SB(0, 1), cB + hstep, voffB); PG8_STAGE(PG8_SA(0, 0), cA, voffA); PG8_STAGE(PG8_SA(0, 1), cA + hstep, voffA);
        if (wr == 1) PG8_BAR;
        PG8_WAIT_V(2); PG8_BAR;
        PG8_STAGE(PG8_SB(1, 0), cB + kstep, voffB); PG8_STAGE(PG8_SA(1, 0), cA + kstep, voffA); PG8_STAGE(PG8_SB(1, 1), cB + hstep + kstep, voffB);
        PG8_WAIT_V(6); PG8_BAR;
    } else {
        PG8_STAGE(PG8_SB(0, 0), cB, voffB); PG8_STAGE(PG8_SA(0, 0), cA, voffA); PG8_STAGE(PG8_SB(0, 1), cB + hstep, voffB); PG8_STAGE(PG8_SA(0, 1), cA + hstep, voffA);
        if (wr == 1) PG8_BAR;
        PG8_WAIT_V(4); PG8_BAR;
        PG8_STAGE(PG8_SB(1, 0), cB + kstep, voffB); PG8_STAGE(PG8_SA(1, 0), cA + kstep, voffA); PG8_STAGE(PG8_SB(1, 1), cB + hstep + kstep, voffB);
        PG8_WAIT_V(6); PG8_BAR;
    }
    for (;;) {
        const bool has_next = S.next(ui + 1, nxt);
        const char* nA = has_next ? (const char*)g.A + (size_t)nxt.pm * tstep : cA; const char* nB = has_next ? (const char*)g.Bt + (size_t)nxt.pn * tstep : cB;
        for (int t = 0; t < nt; t += 2) {
            const bool last = (t == nt - 2);
            const char* a1 = cA + (size_t)(t + 1) * kstep;
            const char* a2 = last ? nA : cA + (size_t)(t + 2) * kstep; const char* b2 = last ? nB : cB + (size_t)(t + 2) * kstep;
            const char* a3 = a2 + kstep; const char* b3 = b2 + kstep;
            if (last && has_next) S.a_ready(nxt);
            if constexpr (SP2) {
            PG8_LDB(B0, 0, 0); PG8_LDB(B1, 0, 1); PG8_SCHED; PG8_LDA(At, 0, 0); PG8_STAGE(PG8_SA(1, 1), a1 + hstep, voffA);
            PG8_WAIT_V(8); PG8_WAIT_L(0); PG8_BAR; PG8_MMA(0, 0, At, B0); PG8_MMA(0, 1, At, B1); PG8_BAR; PG8_SCHED;
            PG8_LDA(At, 0, 1); PG8_STAGE(PG8_SB(0, 0), b2, voffB); PG8_STAGE(PG8_SB(0, 1), b2 + hstep, voffB); PG8_STAGE(PG8_SA(0, 0), a2, voffA);
            PG8_WAIT_V(8); PG8_WAIT_L(0); PG8_BAR; PG8_MMA(1, 0, At, B0); PG8_MMA(1, 1, At, B1); PG8_BAR; PG8_SCHED;
            PG8_LDB(B0, 1, 0); PG8_LDB(B1, 1, 1); PG8_SCHED; PG8_LDA(At, 1, 0); PG8_STAGE(PG8_SA(0, 1), a2 + hstep, voffA);
            PG8_WAIT_V(8); PG8_WAIT_L(0); PG8_BAR; PG8_MMA(0, 0, At, B0); PG8_MMA(0, 1, At, B1); PG8_BAR; PG8_SCHED;
            PG8_LDA(At, 1, 1); PG8_STAGE(PG8_SB(1, 0), b3, voffB); PG8_STAGE(PG8_SB(1, 1), b3 + hstep, voffB); PG8_STAGE(PG8_SA(1, 0), a3, voffA);
            PG8_WAIT_V(8); PG8_WAIT_L(0); PG8_BAR; PG8_MMA(1, 0, At, B0); PG8_MMA(1, 1, At, B1); PG8_BAR; PG8_SCHED;
            } else {
            PG8_LDB(B0, 0, 0); PG8_SCHED; PG8_LDA(At, 0, 0); PG8_STAGE(PG8_SA(1, 1), a1 + hstep, voffA);
            PG8_WAIT_L(8); PG8_BAR; PG8_WAIT_L(0); PG8_MMA(0, 0, At, B0); PG8_BAR; PG8_SCHED;
            PG8_LDB(B1, 0, 1); PG8_STAGE(PG8_SB(0, 0), b2, voffB);
            PG8_BAR; PG8_WAIT_L(0); PG8_MMA(0, 1, At, B1); PG8_BAR;
            PG8_LDA(At, 0, 1); PG8_STAGE(PG8_SA(0, 0), a2, voffA);
            PG8_BAR; PG8_WAIT_L(0); PG8_MMA(1, 0, At, B0); PG8_BAR; PG8_SCHED;
            PG8_STAGE(PG8_SB(0, 1), b2 + hstep, voffB);
            PG8_WAIT_V(6); PG8_BAR; PG8_MMA(1, 1, At, B1); PG8_BAR;
            PG8_LDB(B0, 1, 0); PG8_SCHED; PG8_LDA(At, 1, 0); PG8_STAGE(PG8_SA(0, 1), a2 + hstep, voffA);
            PG8_WAIT_L(8); PG8_BAR; PG8_WAIT_L(0); PG8_MMA(0, 0, At, B0); PG8_BAR; PG8_SCHED;
            PG8_LDB(B1, 1, 1); PG8_STAGE(PG8_SB(1, 0), b3, voffB);
            PG8_BAR; PG8_WAIT_L(0); PG8_MMA(0, 1, At, B1); PG8_BAR;
            PG8_LDA(At, 1, 1); PG8_STAGE(PG8_SA(1, 0), a3, voffA);
            PG8_BAR; PG8_WAIT_L(0); PG8_MMA(1, 0, At, B0); PG8_BAR; PG8_SCHED;
            PG8_STAGE(PG8_SB(1, 1), b3 + hstep, voffB);
            PG8_WAIT_V(6); PG8_BAR; PG8_MMA(1, 1, At, B1); PG8_BAR;
            }
        }
        if constexpr (ALIGN_EPI) { if (wr == 0) PG8_BAR; }
        if constexpr (!Epi::AFTER_DRAIN) { E(acc, cur, wr, wc, fr, fq); S.done(cur); }
        if (!has_next) break;
#pragma unroll
        for (int a = 0; a < 2; ++a)
#pragma unroll
            for (int b = 0; b < 2; ++b)
#pragma unroll
                for (int m = 0; m < 4; ++m)
#pragma unroll
                    for (int n = 0; n < 2; ++n) acc[a][b][m][n] = (f32x4){0.f, 0.f, 0.f, 0.f};
        cur = nxt; cA = nA; cB = nB; ++ui;
        if constexpr (ALIGN_EPI) { if (wr == 1) PG8_BAR; }
    }
    PG8_WAIT_V(0);
    if constexpr (!ALIGN_EPI) { if (wr == 0) PG8_BAR; }
    PG8_BAR;
    if constexpr (Epi::AFTER_DRAIN) { E.fused(acc, cur, wr, wc, fr, fq, lds, wid, lane); S.done(cur); }
#undef PG8_SA
#undef PG8_SB
#undef PG8_STAGE
#undef PG8_LDA
#undef PG8_LDB
#undef PG8_MMA
#undef PG8_WAIT_V
#undef PG8_WAIT_L
#undef PG8_BAR
#undef PG8_SCHED
}
}

using pg8::bf16x8; using pg8::f32x4; using pg8::u32x4;
typedef unsigned short u16;

constexpr int T_ALL = 32768, DM = 1024, TS = 8192;
constexpr int NPAD = 15616, NIN = 15408;
constexpr int RB = 4, NSUP = 128 / RB, SUPT = 64 * RB;
constexpr size_t MiB = 1ull << 20;
constexpr float EPSN = 1e-6f;
constexpr size_t OFF_WIN = 0, OFF_WM = 32 * MiB, OFF_WS = 36 * MiB, OFF_WO = 40 * MiB, OFF_MISC = 42 * MiB;
constexpr size_t OFF_QK = 44 * MiB, OFF_V = 76 * MiB, OFF_XBC = 108 * MiB;
constexpr size_t OFF_MCD = 44 * MiB, OFF_SSD = 76 * MiB, OFF_MCB = 108 * MiB, OFF_SSB = 124 * MiB;
constexpr size_t OFF_G0 = 44 * MiB, OFF_G1 = 60 * MiB;
constexpr size_t OFF_O = 156 * MiB, OFF_ZM = 188 * MiB, OFF_ZS = 220 * MiB, OFF_MG = 252 * MiB, OFF_GF = 284 * MiB;
constexpr size_t OFF_QC = 292 * MiB, OFF_KC = 308 * MiB, OFF_KT = 324 * MiB, OFF_VT = 341 * MiB, OFF_XT = 374 * MiB, OFF_BC = 407 * MiB, OFF_BT = 415 * MiB, OFF_CC = 424 * MiB;
constexpr int TP = TS + 64;
constexpr size_t OFF_P1 = OFF_XT;
constexpr size_t OFF_SCAL = 432 * MiB, OFF_YM = 436 * MiB, OFF_YS = 468 * MiB, WS_END = 500 * MiB;
constexpr int SC_MLA = 0, SC_MLB = 65536, SC_MLP = 131072, SC_MLW = 196608, SC_SSA = 262144, SC_SSD = 524288, SC_SSW = 786432;
constexpr int MI_BIAS = 0, MI_MOD = 16384, MI_MATOT = 32768, MI_MMLOC = 33024, MI_MMST = 33280, MI_SATOT = 33536  , MI_MND = 36864  , MI_MNS = 69632  ;
constexpr size_t OFF_BAR = OFF_MISC + 1 * MiB;
constexpr size_t U_OFF_IN_OUT = 64 * MiB;
constexpr int LDS_BYTES = 147456;
constexpr int XCD_BAR_WORDS_C = 3456;

struct Args { const float* in[19]; float* out; unsigned char* ws; int ph_lo, ph_hi; };

__device__ __forceinline__ float bf2f(u16 b) { return __uint_as_float((unsigned)b << 16); }
__device__ __forceinline__ u16 f2bf(float f) { unsigned r; asm("v_cvt_pk_bf16_f32 %0, %1, %1" : "=v"(r) : "v"(f)); return (u16)r; }
__device__ __forceinline__ unsigned pk2(float lo, float hi) { unsigned r; asm("v_cvt_pk_bf16_f32 %0, %1, %2" : "=v"(r) : "v"(lo), "v"(hi)); return r; }
__device__ __forceinline__ float sigm(float x) { return __builtin_amdgcn_rcpf(1.f + __expf(-x)); }
__device__ __forceinline__ float silu(float x) { return x * __builtin_amdgcn_rcpf(1.f + __expf(-x)); }
__device__ __forceinline__ float softplus_(float x) { return fmaxf(x, 0.f) + log1pf(__expf(-fabsf(x))); }
__device__ __forceinline__ float logsig_(float x) { return fminf(x, 0.f) - log1pf(__expf(-fabsf(x))); }
__device__ __forceinline__ float wave_sum(float v) {
#pragma unroll
    for (int o = 1; o < 64; o <<= 1) v += __shfl_xor(v, o);
    return v;
}
__device__ __forceinline__ float wave_max(float v) {
#pragma unroll
    for (int o = 1; o < 64; o <<= 1) v = fmaxf(v, __shfl_xor(v, o));
    return v;
}
__device__ __forceinline__ float wave_scan_sum(float v, int lane) {
#pragma unroll
    for (int o = 1; o < 64; o <<= 1) { const float t = __shfl_up(v, o); if (lane >= o) v += t; }
    return v;
}
__device__ __forceinline__ float wave_scan_max(float v, int lane) {
#pragma unroll
    for (int o = 1; o < 64; o <<= 1) { const float t = __shfl_up(v, o); if (lane >= o) v = fmaxf(v, t); }
    return v;
}
__device__ __forceinline__ void unpack8(const uint4 v, float (&f)[8]) {
    f[0] = __uint_as_float(v.x << 16); f[1] = __uint_as_float(v.x & 0xffff0000u);
    f[2] = __uint_as_float(v.y << 16); f[3] = __uint_as_float(v.y & 0xffff0000u);
    f[4] = __uint_as_float(v.z << 16); f[5] = __uint_as_float(v.z & 0xffff0000u);
    f[6] = __uint_as_float(v.w << 16); f[7] = __uint_as_float(v.w & 0xffff0000u);
}
__device__ __forceinline__ uint4 pack8(const float (&f)[8]) { uint4 o; o.x = pk2(f[0], f[1]); o.y = pk2(f[2], f[3]); o.z = pk2(f[4], f[5]); o.w = pk2(f[6], f[7]); return o; }
__device__ __forceinline__ int tid_opaque() { int t = threadIdx.x; asm volatile("" : "+v"(t)); return t; }
#define MFMA16(a, b, c) __builtin_amdgcn_mfma_f32_16x16x32_bf16((a), (b), (c), 0, 0, 0)

__device__ __forceinline__ void conv8(const u16* src, int ld, int t, int col, const float* cw, const float* cb, int cstride, float (&o)[8]) {
    const float4 b0 = *(const float4*)(cb + col), b1 = *(const float4*)(cb + col + 4);
    float acc[8] = {b0.x, b0.y, b0.z, b0.w, b1.x, b1.y, b1.z, b1.w};
#pragma unroll
    for (int j = 0; j < 4; ++j) {
        const int tt = t - 3 + j;
        if (tt >= 0) {
            const uint4 v = *(const uint4*)(src + (size_t)tt * ld + col);
            const float4 w0 = *(const float4*)(cw + j * cstride + col), w1 = *(const float4*)(cw + j * cstride + col + 4);
            float x[8]; unpack8(v, x);
            acc[0] += x[0] * w0.x; acc[1] += x[1] * w0.y; acc[2] += x[2] * w0.z; acc[3] += x[3] * w0.w;
            acc[4] += x[4] * w1.x; acc[5] += x[5] * w1.y; acc[6] += x[6] * w1.z; acc[7] += x[7] * w1.w;
        }
    }
#pragma unroll
    for (int e = 0; e < 8; ++e) o[e] = silu(acc[e]);
}

__host__ __device__ __forceinline__ int srccol(int n) {
    if (n < 4096) return n;
    if (n < 8192) { const int t = (n - 4096) >> 8, c = (n - 4096) & 255; return c < 128 ? 4096 + 128 * t + c : 6144 + 128 * t + (c - 128); }
    if (n < 13312) return n + 16;
    if (n < 15360) return n + 48;
    if (n < 15376) return 8192 + (n - 15360);
    if (n < 15408) return 13328 + (n - 15376);
    return -1;
}

__device__ __forceinline__ void tr_item(const float* W, int K, int N, int NOUT, u16* WT, float* scr, int item, int lane, bool remap) {
    const int nblk = NOUT / 32, kb = item / nblk, nb = item % nblk, k0 = 64 * kb, n0 = 32 * nb;
    const int c4 = lane & 7, kr = lane >> 3;
    int src = n0 + 4 * c4; if (remap) src = srccol(src);
    float4 v[8];
#pragma unroll
    for (int i = 0; i < 8; ++i) v[i] = (src >= 0) ? *(const float4*)(W + (size_t)(k0 + 8 * i + kr) * N + src) : make_float4(0.f, 0.f, 0.f, 0.f);
#pragma unroll
    for (int i = 0; i < 8; ++i) { float* d = scr + (8 * i + kr) * 33 + 4 * c4; d[0] = v[i].x; d[1] = v[i].y; d[2] = v[i].z; d[3] = v[i].w; }
    asm volatile("s_waitcnt lgkmcnt(0)" ::: "memory");
    const int c = lane & 7;
#pragma unroll
    for (int j = 0; j < 4; ++j) { const int n = (lane >> 3) + 8 * j; const float* s = scr + (8 * c) * 33 + n;
        uint4 o; o.x = pk2(s[0 * 33], s[1 * 33]); o.y = pk2(s[2 * 33], s[3 * 33]); o.z = pk2(s[4 * 33], s[5 * 33]); o.w = pk2(s[6 * 33], s[7 * 33]);
        *(uint4*)(WT + (size_t)(n0 + n) * K + k0 + 8 * c) = o; }
    asm volatile("s_waitcnt lgkmcnt(0)" ::: "memory");
}
__device__ __forceinline__ void phase0(const Args& a, unsigned char* smem) {
    const int tid = tid_opaque(), lane = tid & 63, wave = __builtin_amdgcn_readfirstlane(tid >> 6), bid = blockIdx.x, G = gridDim.x;
    const float* cvec = a.in[1]; const float* ada_w = a.in[3]; const float* ada_b = a.in[4];
    float* misc = (float*)(a.ws + OFF_MISC);
    float* scv = (float*)smem; float* red = (float*)(smem + 16384);
    for (int i = tid; i < 4096; i += 512) scv[i] = silu(cvec[i]);
    __syncthreads();
    for (int cgp = bid; cgp < 256; cgp += G) {
        const int jj = tid & 15, kq = tid >> 4;
        float s0 = 0.f, s1 = 0.f, s2 = 0.f, s3 = 0.f;
        if (jj < 12) {
            const int j = cgp * 12 + jj;
#pragma unroll 8
            for (int k = kq; k < 1024; k += 32) {
                const float w = ada_w[(size_t)k * 3072 + j];
                s0 += scv[k] * w; s1 += scv[1024 + k] * w; s2 += scv[2048 + k] * w; s3 += scv[3072 + k] * w;
            }
        }
        red[(kq * 16 + jj) * 4 + 0] = s0; red[(kq * 16 + jj) * 4 + 1] = s1; red[(kq * 16 + jj) * 4 + 2] = s2; red[(kq * 16 + jj) * 4 + 3] = s3;
        __syncthreads();
        if (tid < 48) { const int j2 = tid % 12, bb = tid / 12; float s = 0.f; for (int k2 = 0; k2 < 32; ++k2) s += red[(k2 * 16 + j2) * 4 + bb];
            const int j = cgp * 12 + j2; misc[MI_MOD + bb * 3072 + j] = s + ada_b[j]; }
        __syncthreads();
    }
    float* scr = (float*)(smem + 24576 + wave * 8448);
    const int gw = bid * 8 + wave, NGW = G * 8;
    constexpr int I_IN = 16 * (NPAD / 32), I_M = 32 * 32, I_O = 16 * 32;
    for (int it = gw; it < I_IN + 2 * I_M + I_O; it += NGW) {
        int r = it;
        if (r < I_IN) { tr_item(a.in[5], 1024, NIN, NPAD, (u16*)(a.ws + OFF_WIN), scr, r, lane, true); continue; } r -= I_IN;
        if (r < I_M) { tr_item(a.in[15], 2048, 1024, 1024, (u16*)(a.ws + OFF_WM), scr, r, lane, false); continue; } r -= I_M;
        if (r < I_M) { tr_item(a.in[16], 2048, 1024, 1024, (u16*)(a.ws + OFF_WS), scr, r, lane, false); continue; } r -= I_M;
        tr_item(a.in[17], 1024, 1024, 1024, (u16*)(a.ws + OFF_WO), scr, r, lane, false);
    }
    for (int n = bid * 512 + tid; n < NPAD; n += G * 512) { const int s = srccol(n); misc[MI_BIAS + n] = (s >= 0) ? a.in[6][s] : 0.f; }
}

__device__ __forceinline__ void phase1(const Args& a) {
    const int tid = tid_opaque(), lane = tid & 63, wave = __builtin_amdgcn_readfirstlane(tid >> 6);
    const float* x = a.in[0]; const float* nw = a.in[2]; const float* mod = (const float*)(a.ws + OFF_MISC) + MI_MOD;
    u16* U = (u16*)((unsigned char*)a.out + U_OFF_IN_OUT);
    for (int m = blockIdx.x * 8 + wave; m < T_ALL; m += gridDim.x * 8) {
        const float4* xr = (const float4*)(x + (size_t)m * DM) + lane;
        float4 v[4]; float ss = 0.f;
#pragma unroll
        for (int j = 0; j < 4; ++j) { v[j] = xr[64 * j]; ss += v[j].x * v[j].x + v[j].y * v[j].y + v[j].z * v[j].z + v[j].w * v[j].w; }
        const float rstd = rsqrtf(wave_sum(ss) * (1.f / DM) + EPSN);
        const int b = m / TS;
#pragma unroll
        for (int j = 0; j < 4; ++j) {
            const int col = 4 * lane + 256 * j;
            const float4 w = *(const float4*)(nw + col), sh = *(const float4*)(mod + b * 3072 + col), sc = *(const float4*)(mod + b * 3072 + 1024 + col);
            const float u0 = (v[j].x * rstd * w.x) * (1.f + sc.x) + sh.x, u1 = (v[j].y * rstd * w.y) * (1.f + sc.y) + sh.y;
            const float u2 = (v[j].z * rstd * w.z) * (1.f + sc.z) + sh.z, u3 = (v[j].w * rstd * w.w) * (1.f + sc.w) + sh.w;
            uint2 o; o.x = pk2(u0, u1); o.y = pk2(u2, u3);
            *(uint2*)(U + (size_t)m * DM + col) = o;
        }
    }
}

struct EpiProj {
    static constexpr bool PERM = true, AFTER_DRAIN = false;
    unsigned char* ws; const float* bias;
    __device__ __forceinline__ void operator()(const f32x4 (&acc)[2][2][4][2], const pg8::Unit& u, int wr, int wc, int fr, int fq) const {
        const int row0 = u.pm * 256 + wr * 64 + fr, pn = u.pn;
        const float* bp = bias + pn * 256 + wc * 32 + 8 * fq;
        if (pn >= 8 && pn < 16) {
            u16* vt = (u16*)(ws + OFF_VT) + (size_t)((pn - 8) * 256 + wc * 32 + 8 * fq) * TP + row0;
#pragma unroll
            for (int bj = 0; bj < 2; ++bj) {
                const f32x4 b0 = *(const f32x4*)(bp + bj * 128), b1 = *(const f32x4*)(bp + bj * 128 + 4);
#pragma unroll
                for (int ai = 0; ai < 2; ++ai)
#pragma unroll
                    for (int m = 0; m < 4; ++m) { const f32x4 v0 = acc[ai][bj][m][0] + b0, v1 = acc[ai][bj][m][1] + b1;
                        u16* d = vt + (size_t)(bj * 128) * TP + ai * 128 + m * 16;
                        d[0] = f2bf(v0[0]); d[(size_t)TP] = f2bf(v0[1]); d[(size_t)2 * TP] = f2bf(v0[2]); d[(size_t)3 * TP] = f2bf(v0[3]);
                        d[(size_t)4 * TP] = f2bf(v1[0]); d[(size_t)5 * TP] = f2bf(v1[1]); d[(size_t)6 * TP] = f2bf(v1[2]); d[(size_t)7 * TP] = f2bf(v1[3]); }
            }
        } else if (pn >= 16 && pn < 32) {
            u16* gp = (u16*)(ws + OFF_O) + (size_t)row0 * 2048 + (pn - 16) * 128 + wc * 32 + 8 * fq;
            const f32x4 bo0 = *(const f32x4*)(bp), bo1 = *(const f32x4*)(bp + 4), bz0 = *(const f32x4*)(bp + 128), bz1 = *(const f32x4*)(bp + 132);
#pragma unroll
            for (int ai = 0; ai < 2; ++ai)
#pragma unroll
                for (int m = 0; m < 4; ++m) { const f32x4 o0 = acc[ai][0][m][0] + bo0, o1 = acc[ai][0][m][1] + bo1, z0 = acc[ai][1][m][0] + bz0, z1 = acc[ai][1][m][1] + bz1;
                    u32x4 w; w.x = pk2(sigm(o0[0]) * silu(z0[0]), sigm(o0[1]) * silu(z0[1])); w.y = pk2(sigm(o0[2]) * silu(z0[2]), sigm(o0[3]) * silu(z0[3]));
                    w.z = pk2(sigm(o1[0]) * silu(z1[0]), sigm(o1[1]) * silu(z1[1])); w.w = pk2(sigm(o1[2]) * silu(z1[2]), sigm(o1[3]) * silu(z1[3]));
                    *(u32x4*)(gp + (size_t)(ai * 128 + m * 16) * 2048) = w; }
        } else if (pn < 60) {
            u16* base; int ldc, ct;
            if (pn < 32) { const int sg = pn >> 3; base = (u16*)(ws + (sg < 2 ? OFF_QK + (size_t)sg * (32 * MiB) : OFF_O + (size_t)(sg - 2) * (32 * MiB))); ldc = 2048; ct = pn & 7; }
            else if (pn < 44) { base = (u16*)(ws + OFF_XBC); ldc = 3072; ct = pn - 32; }
            else { base = (u16*)(ws + OFF_ZS + (size_t)((pn - 44) >> 3) * (32 * MiB)); ldc = 2048; ct = (pn - 44) & 7; }
            u16* p0 = base + (size_t)row0 * ldc + ct * 256 + wc * 32 + 8 * fq;
            const int act_ = (pn >= 52) ? 2 : ((pn >= 44) ? 1 : 0);
#pragma unroll
            for (int bj = 0; bj < 2; ++bj) {
                const f32x4 b0 = *(const f32x4*)(bp + bj * 128), b1 = *(const f32x4*)(bp + bj * 128 + 4);
#pragma unroll
                for (int ai = 0; ai < 2; ++ai)
#pragma unroll
                    for (int m = 0; m < 4; ++m) { f32x4 v0 = acc[ai][bj][m][0] + b0, v1 = acc[ai][bj][m][1] + b1;
                        if (act_ == 1) {
#pragma unroll
                            for (int e = 0; e < 4; ++e) { v0[e] = silu(v0[e]); v1[e] = silu(v1[e]); } }
                        else if (act_ == 2) {
#pragma unroll
                            for (int e = 0; e < 4; ++e) { v0[e] = sigm(v0[e]); v1[e] = sigm(v1[e]); } }
                        u32x4 w; w.x = pk2(v0[0], v0[1]); w.y = pk2(v0[2], v0[3]); w.z = pk2(v1[0], v1[1]); w.w = pk2(v1[2], v1[3]);
                        *(u32x4*)(p0 + (size_t)(ai * 128 + m * 16) * ldc + bj * 128) = w; }
            }
        } else {
            float* p0 = (float*)(ws + OFF_GF) + (size_t)row0 * 256 + wc * 32 + 8 * fq;
            const f32x4 b0 = *(const f32x4*)(bp), b1 = *(const f32x4*)(bp + 4);
#pragma unroll
            for (int ai = 0; ai < 2; ++ai)
#pragma unroll
                for (int m = 0; m < 4; ++m) { float* rowp = p0 + (size_t)(ai * 128 + m * 16) * 256;
                    *(f32x4*)(rowp) = acc[ai][0][m][0] + b0; *(f32x4*)(rowp + 4) = acc[ai][0][m][1] + b1; }
        }
    }
};
struct EpiMerge {
    static constexpr bool PERM = true, AFTER_DRAIN = false;
    const u16* mg; u16* G; int sel;
    __device__ __forceinline__ void operator()(const f32x4 (&acc)[2][2][4][2], const pg8::Unit& u, int wr, int wc, int fr, int fq) const {
        const int row0 = u.pm * 256 + wr * 64 + fr, col0 = u.pn * 256 + wc * 32 + 8 * fq;
#pragma unroll
        for (int ai = 0; ai < 2; ++ai)
#pragma unroll
            for (int m = 0; m < 4; ++m) { const int row = row0 + ai * 128 + m * 16;
#pragma unroll
                for (int bj = 0; bj < 2; ++bj) { const int col = col0 + bj * 128;
                    const uint4 gq = *(const uint4*)(mg + (size_t)row * 2048 + sel * 1024 + col); float g[8]; unpack8(gq, g);
                    const f32x4 a0 = acc[ai][bj][m][0], a1 = acc[ai][bj][m][1];
                    u32x4 w; w.x = pk2(a0[0] * g[0], a0[1] * g[1]); w.y = pk2(a0[2] * g[2], a0[3] * g[3]);
                    w.z = pk2(a1[0] * g[4], a1[1] * g[5]); w.w = pk2(a1[2] * g[6], a1[3] * g[7]);
                    *(u32x4*)(G + (size_t)row * 1024 + col) = w; } }
    }
};
struct EpiOut {
    static constexpr bool PERM = true, AFTER_DRAIN = false;
    u16* C; int ldc;
    __device__ __forceinline__ void operator()(const f32x4 (&acc)[2][2][4][2], const pg8::Unit& u, int wr, int wc, int fr, int fq) const {
        const int row0 = u.pm * 256 + wr * 64 + fr, col0 = u.pn * 256 + wc * 32 + 8 * fq;
#pragma unroll
        for (int ai = 0; ai < 2; ++ai)
#pragma unroll
            for (int m = 0; m < 4; ++m) { u16* rowp = C + (size_t)(row0 + ai * 128 + m * 16) * ldc + col0;
#pragma unroll
                for (int bj = 0; bj < 2; ++bj) { const f32x4 v0 = acc[ai][bj][m][0], v1 = acc[ai][bj][m][1];
                    u32x4 w; w.x = pk2(v0[0], v0[1]); w.y = pk2(v0[2], v0[3]); w.z = pk2(v1[0], v1[1]); w.w = pk2(v1[2], v1[3]);
                    *(u32x4*)(rowp + bj * 128) = w; } }
    }
};

__device__ __forceinline__ unsigned lo16pair(unsigned a, unsigned b) { return (a & 0xffffu) | (b << 16); }
__device__ __forceinline__ unsigned hi16pair(unsigned a, unsigned b) { return (a >> 16) | (b & 0xffff0000u); }
__device__ __forceinline__ unsigned u4w(const uint4& v, int w) { return w == 0 ? v.x : (w == 1 ? v.y : (w == 2 ? v.z : v.w)); }
__device__ __forceinline__ void store_transposed(const uint4 (&pk)[8], u16* T, int row0, int tcol) {
#pragma unroll
    for (int e = 0; e < 8; ++e) {
        const int w = e >> 1; uint4 o;
        if ((e & 1) == 0) { o.x = lo16pair(u4w(pk[0], w), u4w(pk[1], w)); o.y = lo16pair(u4w(pk[2], w), u4w(pk[3], w)); o.z = lo16pair(u4w(pk[4], w), u4w(pk[5], w)); o.w = lo16pair(u4w(pk[6], w), u4w(pk[7], w)); }
        else { o.x = hi16pair(u4w(pk[0], w), u4w(pk[1], w)); o.y = hi16pair(u4w(pk[2], w), u4w(pk[3], w)); o.z = hi16pair(u4w(pk[4], w), u4w(pk[5], w)); o.w = hi16pair(u4w(pk[6], w), u4w(pk[7], w)); }
        *(uint4*)(T + (size_t)(row0 + e) * TP + tcol) = o;
    }
}
__device__ __forceinline__ void phase_conv(const Args& a) {
    const int tid = tid_opaque(), lane = tid & 63, wave = __builtin_amdgcn_readfirstlane(tid >> 6);
    const int piece = lane & 7, tg = lane >> 3;
    const int gw = blockIdx.x * 8 + wave, NGW = gridDim.x * 8;
    float* misc = (float*)(a.ws + OFF_MISC); float* scal = (float*)(a.ws + OFF_SCAL); const float* GF = (const float*)(a.ws + OFF_GF);
    const bool even_ = (gridDim.x == 256);
    for (int task = even_ ? ((wave < 5) ? (int)blockIdx.x * 5 + wave : 1280) : gw; task < 1280; task += even_ ? 1280 : NGW) {
        if (task < 256) {
            const int h = task & 7, sc = task >> 3, ts = sc * SUPT;
            float fp[RB], ip[RB];
#pragma unroll
            for (int blk = 0; blk < RB; ++blk) { const int t = ts + blk * 64 + lane; fp[blk] = GF[(size_t)t * 256 + 8 + h]; ip[blk] = GF[(size_t)t * 256 + h]; }
            float carry = 0.f, pm = -3.0e38f, bv[RB];
#pragma unroll
            for (int blk = 0; blk < RB; ++blk) { const int t = ts + blk * 64 + lane;
                const float av = wave_scan_sum(logsig_(fp[blk]), lane) + carry; carry = __shfl(av, 63);
                const float b = ip[blk] - av; bv[blk] = b;
                const float plm = fmaxf(wave_scan_max(b, lane), pm); pm = __shfl(plm, 63);
                scal[SC_MLA + h * TS + t] = av; scal[SC_MLB + h * TS + t] = b; scal[SC_MLP + h * TS + t] = plm; }
#pragma unroll
            for (int blk = 0; blk < RB; ++blk) scal[SC_MLW + h * TS + ts + blk * 64 + lane] = __expf(bv[blk] - pm);
            if (lane == 0) { misc[MI_MATOT + h * NSUP + sc] = carry; misc[MI_MMLOC + h * NSUP + sc] = carry + pm; }
        } else {
            const int x = task - 256, hh = x & 31, sc = x >> 5, ts = sc * SUPT;
            const float Ah = -__expf(a.in[12][hh]);
            float dtr[RB];
#pragma unroll
            for (int blk = 0; blk < RB; ++blk) dtr[blk] = GF[(size_t)(ts + blk * 64 + lane) * 256 + 16 + hh];
            float carry = 0.f, av[RB], dv[RB];
#pragma unroll
            for (int blk = 0; blk < RB; ++blk) { const int t = ts + blk * 64 + lane;
                const float dt = softplus_(dtr[blk]);
                av[blk] = wave_scan_sum(dt * Ah, lane) + carry; carry = __shfl(av[blk], 63); dv[blk] = dt;
                scal[SC_SSA + hh * TS + t] = av[blk]; scal[SC_SSD + hh * TS + t] = dt; }
#pragma unroll
            for (int blk = 0; blk < RB; ++blk) scal[SC_SSW + hh * TS + ts + blk * 64 + lane] = __expf(carry - av[blk]) * dv[blk];
            if (lane == 0) misc[MI_SATOT + hh * NSUP + sc] = carry;
        }
    }
    for (int wt = gw; wt < 112 * 128; wt += NGW) {
        const int gidx = wt >> 7, tb = wt & 127, t0 = tb * 64 + 8 * tg;
        if (gidx >= 32 && gidx < 64) continue;
        if (false) {
            const int col = (gidx - 32) * 64 + piece * 8;
            const u16* V = (const u16*)(a.ws + OFF_V);
            uint4 pk[8];
#pragma unroll
            for (int i = 0; i < 8; ++i) pk[i] = *(const uint4*)(V + (size_t)(t0 + i) * 2048 + col);
            store_transposed(pk, (u16*)(a.ws + OFF_VT), col, t0);
            continue;
        }
        const u16* src; int ld, scol; const float* cw; const float* cb; int cstride;
        u16* rowdst = nullptr; int rld = 0, rcol = 0; u16* trdst = nullptr; int trow = 0; float scale = 1.f;
        if (gidx < 16) { src = (const u16*)(a.ws + OFF_QK); ld = 2048; scol = gidx * 64; cw = a.in[7]; cb = a.in[8]; cstride = 2048;
            rowdst = (u16*)(a.ws + OFF_QC); rld = 1024; rcol = gidx * 64; scale = 0.08838834764831845f; }
        else if (gidx < 32) { src = (const u16*)(a.ws + OFF_QK); ld = 2048; scol = 1024 + (gidx - 16) * 64; cw = a.in[7]; cb = a.in[8]; cstride = 2048;
            rowdst = (u16*)(a.ws + OFF_KC); rld = 1024; rcol = (gidx - 16) * 64; trdst = (u16*)(a.ws + OFF_KT); trow = (gidx - 16) * 64; }
        else if (gidx < 96) { src = (const u16*)(a.ws + OFF_XBC); ld = 3072; scol = (gidx - 64) * 64; cw = a.in[10]; cb = a.in[11]; cstride = 3072;
            trdst = (u16*)(a.ws + OFF_XT); trow = (gidx - 64) * 64; }
        else if (gidx < 104) { src = (const u16*)(a.ws + OFF_XBC); ld = 3072; scol = 2048 + (gidx - 96) * 64; cw = a.in[10]; cb = a.in[11]; cstride = 3072;
            rowdst = (u16*)(a.ws + OFF_BC); rld = 512; rcol = (gidx - 96) * 64; trdst = (u16*)(a.ws + OFF_BT); trow = (gidx - 96) * 64; }
        else { src = (const u16*)(a.ws + OFF_XBC); ld = 3072; scol = 2560 + (gidx - 104) * 64; cw = a.in[10]; cb = a.in[11]; cstride = 3072;
            rowdst = (u16*)(a.ws + OFF_CC); rld = 512; rcol = (gidx - 104) * 64; }
        const int col = scol + piece * 8;
        uint4 raw[11];
#pragma unroll
        for (int i = 0; i < 11; ++i) { const int tt = t0 - 3 + i; raw[i] = (tt >= 0) ? *(const uint4*)(src + (size_t)tt * ld + col) : make_uint4(0u, 0u, 0u, 0u); }
        float w[4][8], bs[8];
#pragma unroll
        for (int j = 0; j < 4; ++j) { const float4 w0 = *(const float4*)(cw + j * cstride + col), w1 = *(const float4*)(cw + j * cstride + col + 4);
            w[j][0] = w0.x; w[j][1] = w0.y; w[j][2] = w0.z; w[j][3] = w0.w; w[j][4] = w1.x; w[j][5] = w1.y; w[j][6] = w1.z; w[j][7] = w1.w; }
        { const float4 b0 = *(const float4*)(cb + col), b1 = *(const float4*)(cb + col + 4);
          bs[0] = b0.x; bs[1] = b0.y; bs[2] = b0.z; bs[3] = b0.w; bs[4] = b1.x; bs[5] = b1.y; bs[6] = b1.z; bs[7] = b1.w; }
        uint4 pk[8];
#pragma unroll
        for (int i = 0; i < 8; ++i) {
            float acc[8];
#pragma unroll
            for (int e = 0; e < 8; ++e) acc[e] = bs[e];
#pragma unroll
            for (int j = 0; j < 4; ++j) { float x[8]; unpack8(raw[i + j], x);
#pragma unroll
                for (int e = 0; e < 8; ++e) acc[e] += x[e] * w[j][e]; }
#pragma unroll
            for (int e = 0; e < 8; ++e) acc[e] = silu(acc[e]) * scale;
            pk[i] = pack8(acc);
            if (rowdst) *(uint4*)(rowdst + (size_t)(t0 + i) * rld + rcol + piece * 8) = pk[i];
        }
        if (trdst) store_transposed(pk, trdst, trow + piece * 8, t0);
    }
}

__device__ __forceinline__ bf16x8 scale_frag(const uint4 v, const float4 w0, const float4 w1) {
    float f[8]; unpack8(v, f);
    f[0] *= w0.x; f[1] *= w0.y; f[2] *= w0.z; f[3] *= w0.w; f[4] *= w1.x; f[5] *= w1.y; f[6] *= w1.z; f[7] *= w1.w;
    const uint4 p = pack8(f); return __builtin_bit_cast(bf16x8, p);
}
#define LDFRAG(ptr) (*(const bf16x8*)(ptr))

#define P1_GLOAD(blk) do { const int tk0_ = ts + 64 * (blk); \
        ar0 = *(const uint4*)(Abase + (size_t)(srow) * TP + tk0_ + spc); ar1 = *(const uint4*)(Abase + (size_t)(64 + srow) * TP + tk0_ + spc); \
        ar2 = *(const uint4*)(Abase + (size_t)(128 + srow) * TP + tk0_ + spc); ar3 = *(const uint4*)(Abase + (size_t)(192 + srow) * TP + tk0_ + spc); \
        br0 = *(const uint4*)(Bbase + (size_t)(srow) * TP + tk0_ + spc); br1 = *(const uint4*)(Bbase + (size_t)(64 + srow) * TP + tk0_ + spc); } while (0)
#define P1_LSTORE(stage) do { u16* As_ = (u16*)(smem + (stage) * 55296); u16* Bs_ = As_ + 18432; \
        *(uint4*)(As_ + srow * 72 + spc) = ar0; *(uint4*)(As_ + (64 + srow) * 72 + spc) = ar1; *(uint4*)(As_ + (128 + srow) * 72 + spc) = ar2; *(uint4*)(As_ + (192 + srow) * 72 + spc) = ar3; \
        *(uint4*)(Bs_ + srow * 72 + spc) = br0; *(uint4*)(Bs_ + (64 + srow) * 72 + spc) = br1; } while (0)
__device__ __forceinline__ void ml_pass1(const Args& a, unsigned char* smem, int h, int sc) {
    const int tid = tid_opaque(), lane = tid & 63, wave = __builtin_amdgcn_readfirstlane(tid >> 6), r = lane & 15, q = lane >> 4;
    const u16* KT = (const u16*)(a.ws + OFF_KT); const u16* VT = (const u16*)(a.ws + OFF_VT);
    float* misc = (float*)(a.ws + OFF_MISC);
    const int ts = sc * SUPT, srow = tid >> 3, spc = (tid & 7) * 8;
    const float* wkp = (const float*)(a.ws + OFF_SCAL) + SC_MLW + h * TS + ts;
    const u16* Abase = VT + (size_t)(h * 256) * TP; const u16* Bbase = KT + (size_t)(h * 128) * TP;
    uint4 ar0, ar1, ar2, ar3, br0, br1;
    P1_GLOAD(0);
    float* swk = (float*)(smem + 110592);
    if (tid < 256) swk[tid] = wkp[tid];
    float nacc = 0.f;
    f32x4 acc[2][8];
#pragma unroll
    for (int i = 0; i < 2; ++i)
#pragma unroll
        for (int j = 0; j < 8; ++j) acc[i][j] = (f32x4){0.f, 0.f, 0.f, 0.f};
#pragma unroll 1
    for (int blk = 0; blk < RB; ++blk) {
        P1_LSTORE(blk & 1);
        __syncthreads();
        if (blk + 1 < RB) P1_GLOAD(blk + 1);
        const u16* As = (const u16*)(smem + (blk & 1) * 55296); const u16* Bs = As + 18432;
#pragma unroll
        for (int ks = 0; ks < 2; ++ks) {
            const float4 w0 = *(const float4*)(swk + 64 * blk + 32 * ks + 8 * q), w1 = *(const float4*)(swk + 64 * blk + 32 * ks + 8 * q + 4);
            bf16x8 af[2];
#pragma unroll
            for (int mt = 0; mt < 2; ++mt) af[mt] = scale_frag(*(const uint4*)(As + (32 * wave + 16 * mt + r) * 72 + 32 * ks + 8 * q), w0, w1);
#pragma unroll
            for (int nt = 0; nt < 8; ++nt) { const bf16x8 bfr = *(const bf16x8*)(Bs + (16 * nt + r) * 72 + 32 * ks + 8 * q);
#pragma unroll
                for (int mt = 0; mt < 2; ++mt) acc[mt][nt] = MFMA16(bfr, af[mt], acc[mt][nt]); }
        }
        if (tid < 128) {
#pragma unroll
            for (int c8 = 0; c8 < 8; ++c8) { const uint4 v = *(const uint4*)(Bs + tid * 72 + c8 * 8); float kf_[8]; unpack8(v, kf_);
                const float4 w0 = *(const float4*)(swk + 64 * blk + c8 * 8), w1 = *(const float4*)(swk + 64 * blk + c8 * 8 + 4);
                nacc += kf_[0] * w0.x + kf_[1] * w0.y + kf_[2] * w0.z + kf_[3] * w0.w + kf_[4] * w1.x + kf_[5] * w1.y + kf_[6] * w1.z + kf_[7] * w1.w; } }
    }
    u16* dst = (u16*)(a.ws + OFF_MCD) + ((size_t)(h * NSUP + sc) * 256) * 128;
#pragma unroll
    for (int mt = 0; mt < 2; ++mt)
#pragma unroll
        for (int nt = 0; nt < 8; ++nt)
        { uint2 o; o.x = pk2(acc[mt][nt][0], acc[mt][nt][1]); o.y = pk2(acc[mt][nt][2], acc[mt][nt][3]); *(uint2*)(dst + (size_t)(32 * wave + 16 * mt + r) * 128 + 16 * nt + 4 * q) = o; }
    if (tid < 128) misc[MI_MND + (h * NSUP + sc) * 128 + tid] = nacc;
    __syncthreads();
}
__device__ __forceinline__ void ssd_pass1(const Args& a, unsigned char* smem, int g, int sc, int hhalf) {
    const int tid = tid_opaque(), lane = tid & 63, wave = __builtin_amdgcn_readfirstlane(tid >> 6), r = lane & 15, q = lane >> 4;
    const u16* XT = (const u16*)(a.ws + OFF_XT); const u16* BT = (const u16*)(a.ws + OFF_BT);
    const int ts = sc * SUPT, hl = wave >> 1, nh = wave & 1, hh = g * 8 + hhalf * 4 + hl, srow = tid >> 3, spc = (tid & 7) * 8;
    const u16* Abase = XT + (size_t)((g * 8 + hhalf * 4) * 64) * TP; const u16* Bbase = BT + (size_t)(g * 128) * TP;
    const float* swh = (const float*)(a.ws + OFF_SCAL) + SC_SSW + hh * TS + ts + 8 * q;
    uint4 ar0, ar1, ar2, ar3, br0, br1;
    P1_GLOAD(0);
    float* ssw = (float*)(smem + 110592);
    { const int hl2 = tid >> 7, tk2 = (tid & 127) * 2;
      *(float2*)(ssw + hl2 * 256 + tk2) = *(const float2*)((const float*)(a.ws + OFF_SCAL) + SC_SSW + (size_t)(g * 8 + hhalf * 4 + hl2) * TS + ts + tk2); }
    f32x4 acc[4][4];
#pragma unroll
    for (int i = 0; i < 4; ++i)
#pragma unroll
        for (int j = 0; j < 4; ++j) acc[i][j] = (f32x4){0.f, 0.f, 0.f, 0.f};
#pragma unroll 1
    for (int blk = 0; blk < RB; ++blk) {
        P1_LSTORE(blk & 1);
        __syncthreads();
        if (blk + 1 < RB) P1_GLOAD(blk + 1);
        const u16* As = (const u16*)(smem + (blk & 1) * 55296); const u16* Bs = As + 18432;
#pragma unroll
        for (int ks = 0; ks < 2; ++ks) {
            const float4 w0 = *(const float4*)(ssw + hl * 256 + 64 * blk + 32 * ks + 8 * q), w1 = *(const float4*)(ssw + hl * 256 + 64 * blk + 32 * ks + 8 * q + 4);
            bf16x8 af[4];
#pragma unroll
            for (int mt = 0; mt < 4; ++mt) af[mt] = scale_frag(*(const uint4*)(As + (hl * 64 + 16 * mt + r) * 72 + 32 * ks + 8 * q), w0, w1);
#pragma unroll
            for (int nt = 0; nt < 4; ++nt) { const bf16x8 bfr = *(const bf16x8*)(Bs + (64 * nh + 16 * nt + r) * 72 + 32 * ks + 8 * q);
#pragma unroll
                for (int mt = 0; mt < 4; ++mt) acc[mt][nt] = MFMA16(bfr, af[mt], acc[mt][nt]); }
        }
    }
    u16* dst = (u16*)(a.ws + OFF_SSD) + ((size_t)(hh * NSUP + sc) * 64) * 128;
#pragma unroll
    for (int mt = 0; mt < 4; ++mt)
#pragma unroll
        for (int nt = 0; nt < 4; ++nt)
        { uint2 o; o.x = pk2(acc[mt][nt][0], acc[mt][nt][1]); o.y = pk2(acc[mt][nt][2], acc[mt][nt][3]); *(uint2*)(dst + (size_t)(16 * mt + r) * 128 + 64 * nh + 16 * nt + 4 * q) = o; }
    __syncthreads();
}
#undef P1_GLOAD
#undef P1_LSTORE

__device__ __forceinline__ void phase_scan(const Args& a, unsigned char* smem) {
    const int tid = tid_opaque();
    const int gt = blockIdx.x * 512 + tid, total = gridDim.x * 512;
    float* misc = (float*)(a.ws + OFF_MISC);
    float* tdec = (float*)smem; float* twl = tdec + NSUP; float* tdec2 = twl + NSUP; float* tat = tdec2 + NSUP; float* tml = tat + NSUP; float* tm = tml + NSUP;
    for (int p = gt; p < 131072; p += total) {
        const int h = p >> 14, rem = p & 16383, hh = p >> 12, rem2 = p & 4095;
        const unsigned* dl = (const unsigned*)((const u16*)(a.ws + OFF_MCD) + (size_t)h * NSUP * 32768) + rem;
        unsigned* ob = (unsigned*)((u16*)(a.ws + OFF_MCB) + (size_t)h * NSUP * 32768) + rem;
        const unsigned* dl2 = (const unsigned*)((const u16*)(a.ws + OFF_SSD) + (size_t)hh * NSUP * 8192) + rem2;
        unsigned* ob2 = (unsigned*)((u16*)(a.ws + OFF_SSB) + (size_t)hh * NSUP * 8192) + rem2;
        unsigned d[16], e[16];
#pragma unroll
        for (int u = 0; u < 16; ++u) { d[u] = dl[(size_t)u * 16384]; e[u] = dl2[(size_t)u * 4096]; }
        __syncthreads();
        if (tid < NSUP) { tat[tid] = misc[MI_MATOT + h * NSUP + tid]; tml[tid] = misc[MI_MMLOC + h * NSUP + tid]; tdec2[tid] = __expf(misc[MI_SATOT + hh * NSUP + tid]); }
        __syncthreads();
        if (tid == 0) { float m = 0.f;
            for (int sc = 0; sc < NSUP; ++sc) { const float at = tat[sc], ml = tml[sc]; tm[sc] = m;
                const float mn = fmaxf(at + m, ml); tdec[sc] = __expf(at + m - mn); twl[sc] = __expf(ml - mn); m = mn; } }
        __syncthreads();
        if (((p - tid) & 16383) == 0 && tid < NSUP) misc[MI_MMST + h * NSUP + tid] = tm[tid];
        float2 C = {0.f, 0.f}, nv = {0.f, 0.f}, S = {0.f, 0.f};
        const bool do_n = rem < 64;
        for (int s0 = 0; s0 < NSUP; s0 += 16) {
            if (s0 > 0) {
#pragma unroll
                for (int u = 0; u < 16; ++u) { d[u] = dl[(size_t)(s0 + u) * 16384]; e[u] = dl2[(size_t)(s0 + u) * 4096]; } }
#pragma unroll
            for (int u = 0; u < 16; ++u) { const int sc = s0 + u;
                ob[(size_t)sc * 16384] = pk2(C.x, C.y);
                ob2[(size_t)sc * 4096] = pk2(S.x, S.y);
                const float dec = tdec[sc], wl = twl[sc], dec2 = tdec2[sc];
                if (do_n) { ((float2*)(misc + MI_MNS + (h * NSUP + sc) * 128))[rem] = nv;
                    const float2 dn = ((const float2*)(misc + MI_MND + (h * NSUP + sc) * 128))[rem]; nv.x = dec * nv.x + wl * dn.x; nv.y = dec * nv.y + wl * dn.y; }
                C.x = dec * C.x + wl * __uint_as_float(d[u] << 16); C.y = dec * C.y + wl * __uint_as_float(d[u] & 0xffff0000u);
                S.x = dec2 * S.x + __uint_as_float(e[u] << 16); S.y = dec2 * S.y + __uint_as_float(e[u] & 0xffff0000u); }
        }
    }
}

__device__ __forceinline__ void ml_pass2(const Args& a, unsigned char* smem, int h, int c) {
    const int tid = tid_opaque(), lane = tid & 63, wave = __builtin_amdgcn_readfirstlane(tid >> 6), r = lane & 15, q = lane >> 4;
    u16* Qs = (u16*)smem; u16* Ps = (u16*)(smem + 125952);
    float* sbk = (float*)(smem + 144384); float* spm = sbk + 256; float* sam = spm + 64; float* srd = sam + 64; float* sqn = srd + 64;
    float* Ht = (float*)(smem + 17408);
    const u16* QC = (const u16*)(a.ws + OFF_QC); const u16* KC = (const u16*)(a.ws + OFF_KC); const u16* VT = (const u16*)(a.ws + OFF_VT);
    const u16* O = (const u16*)(a.ws + OFF_O); const u16* ZM = (const u16*)(a.ws + OFF_ZM);
    const float* misc = (const float*)(a.ws + OFF_MISC);
    const int sc = c / RB, j = c % RB, t0 = c * 64, ts = sc * SUPT;
    uint4 kr0, kr1, vr0, vr1, vr2, vr3;
    const int kidx_t = tid >> 4, kidx_p = (tid & 15) * 8, vidx_d = tid >> 3, vidx_p = (tid & 7) * 8;
#define ML2_GLOAD(blk) do { const int tk0_ = ts + 64 * (blk); \
        kr0 = *(const uint4*)(KC + (size_t)(tk0_ + kidx_t) * 1024 + h * 128 + kidx_p); kr1 = *(const uint4*)(KC + (size_t)(tk0_ + 32 + kidx_t) * 1024 + h * 128 + kidx_p); \
        vr0 = *(const uint4*)(VT + (size_t)(h * 256 + vidx_d) * TP + tk0_ + vidx_p); vr1 = *(const uint4*)(VT + (size_t)(h * 256 + 64 + vidx_d) * TP + tk0_ + vidx_p); \
        vr2 = *(const uint4*)(VT + (size_t)(h * 256 + 128 + vidx_d) * TP + tk0_ + vidx_p); vr3 = *(const uint4*)(VT + (size_t)(h * 256 + 192 + vidx_d) * TP + tk0_ + vidx_p); } while (0)
#define ML2_LSTORE(stage) do { u16* Ks_ = (u16*)(smem + 17408 + (stage) * 54272); u16* Vs_ = Ks_ + 8704; \
        *(uint4*)(Ks_ + kidx_t * 136 + kidx_p) = kr0; *(uint4*)(Ks_ + (32 + kidx_t) * 136 + kidx_p) = kr1; \
        *(uint4*)(Vs_ + vidx_d * 72 + vidx_p) = vr0; *(uint4*)(Vs_ + (64 + vidx_d) * 72 + vidx_p) = vr1; *(uint4*)(Vs_ + (128 + vidx_d) * 72 + vidx_p) = vr2; *(uint4*)(Vs_ + (192 + vidx_d) * 72 + vidx_p) = vr3; } while (0)
    ML2_GLOAD(0);
    bf16x8 cfr[2][4];
    { const u16* CT = (const u16*)(a.ws + OFF_MCB) + ((size_t)(h * NSUP + sc) * 256) * 128 + (size_t)(32 * wave + r) * 128 + 8 * q;
#pragma unroll
      for (int n2 = 0; n2 < 2; ++n2)
#pragma unroll
          for (int ks = 0; ks < 4; ++ks) cfr[n2][ks] = LDFRAG(CT + (size_t)(16 * n2) * 128 + 32 * ks); }
    const float mst = misc[MI_MMST + h * NSUP + sc];
    { const float* scal = (const float*)(a.ws + OFF_SCAL);
      if (tid < 64 * (j + 1)) sbk[tid] = scal[SC_MLB + h * TS + ts + tid];
      if (tid >= 256 && tid < 320) { const int l = tid - 256; const float pmx = fmaxf(scal[SC_MLP + h * TS + t0 + l], mst); spm[l] = pmx; sam[l] = scal[SC_MLA + h * TS + t0 + l] + pmx; } }
    const uint4 qr0 = *(const uint4*)(QC + (size_t)(t0 + kidx_t) * 1024 + h * 128 + kidx_p), qr1 = *(const uint4*)(QC + (size_t)(t0 + 32 + kidx_t) * 1024 + h * 128 + kidx_p);
    {
      const float* nv = misc + MI_MNS + (h * NSUP + sc) * 128 + 16 * (tid & 7); const u16* qr = QC + (size_t)(t0 + (tid >> 3)) * 1024 + h * 128 + 16 * (tid & 7);
      const uint4 v0 = *(const uint4*)qr, v1 = *(const uint4*)(qr + 8); float f0[8], f1[8]; unpack8(v0, f0); unpack8(v1, f1);
      const float4 n0 = *(const float4*)nv, n1 = *(const float4*)(nv + 4), n2 = *(const float4*)(nv + 8), n3 = *(const float4*)(nv + 12);
      float sq = f0[0] * n0.x + f0[1] * n0.y + f0[2] * n0.z + f0[3] * n0.w + f0[4] * n1.x + f0[5] * n1.y + f0[6] * n1.z + f0[7] * n1.w
               + f1[0] * n2.x + f1[1] * n2.y + f1[2] * n2.z + f1[3] * n2.w + f1[4] * n3.x + f1[5] * n3.y + f1[6] * n3.z + f1[7] * n3.w;
      sq += __shfl_xor(sq, 1); sq += __shfl_xor(sq, 2); sq += __shfl_xor(sq, 4);
      if ((tid & 7) == 0) sqn[tid >> 3] = sq; }
    *(uint4*)(Qs + kidx_t * 136 + kidx_p) = qr0; *(uint4*)(Qs + (32 + kidx_t) * 136 + kidx_p) = qr1;
    ML2_LSTORE(0);
    __syncthreads();
    f32x4 acc[4][2];
#pragma unroll
    for (int i = 0; i < 4; ++i)
#pragma unroll
        for (int k = 0; k < 2; ++k) acc[i][k] = (f32x4){0.f, 0.f, 0.f, 0.f};
    {
#pragma unroll
      for (int ks = 0; ks < 4; ++ks) {
          bf16x8 af[4];
#pragma unroll
          for (int mt = 0; mt < 4; ++mt) af[mt] = *(const bf16x8*)(Qs + (16 * mt + r) * 136 + 32 * ks + 8 * q);
#pragma unroll
          for (int mt = 0; mt < 4; ++mt) { acc[mt][0] = MFMA16(af[mt], cfr[0][ks], acc[mt][0]); acc[mt][1] = MFMA16(af[mt], cfr[1][ks], acc[mt][1]); }
      }
#pragma unroll
      for (int mt = 0; mt < 4; ++mt)
#pragma unroll
          for (int jj = 0; jj < 4; ++jj) { const float wi = __expf(mst - spm[16 * mt + 4 * q + jj]); acc[mt][0][jj] *= wi; acc[mt][1][jj] *= wi; } }
    const int mtS = wave >> 1;
    bf16x8 qf[4];
#pragma unroll
    for (int ks = 0; ks < 4; ++ks) qf[ks] = *(const bf16x8*)(Qs + (16 * mtS + r) * 136 + 32 * ks + 8 * q);
    float den = 0.f;
#pragma unroll 1
    for (int i = 0; i <= j; ++i) {
        const u16* Ks = (const u16*)(smem + 17408 + (i & 1) * 54272); const u16* VTs = Ks + 8704;
        if (i < j) ML2_GLOAD(i + 1);
        u16* P = Ps + (i & 1) * 4608;
        { f32x4 s2[2] = {(f32x4){0.f, 0.f, 0.f, 0.f}, (f32x4){0.f, 0.f, 0.f, 0.f}};
#pragma unroll
          for (int ks = 0; ks < 4; ++ks)
#pragma unroll
              for (int u = 0; u < 2; ++u) s2[u] = MFMA16(qf[ks], *(const bf16x8*)(Ks + (16 * ((wave & 1) * 2 + u) + r) * 136 + 32 * ks + 8 * q), s2[u]);
#pragma unroll
          for (int u = 0; u < 2; ++u) { const int s = 16 * ((wave & 1) * 2 + u) + r; const float bs = sbk[i * 64 + s];
#pragma unroll
              for (int jj = 0; jj < 4; ++jj) { const int l = 16 * mtS + 4 * q + jj;
                  const float w = __expf(fminf(bs - spm[l], 0.f)); const bool ok = (i < j) || (s <= l);
                  P[l * 72 + s] = f2bf(ok ? s2[u][jj] * w : 0.f); } } }
        __syncthreads();
        if (i < j) ML2_LSTORE((i + 1) & 1);
#pragma unroll
        for (int ks = 0; ks < 2; ++ks) {
            bf16x8 af[4];
#pragma unroll
            for (int mt = 0; mt < 4; ++mt) af[mt] = *(const bf16x8*)(P + (16 * mt + r) * 72 + 32 * ks + 8 * q);
#pragma unroll
            for (int n2 = 0; n2 < 2; ++n2) { const bf16x8 bfr = *(const bf16x8*)(VTs + (32 * wave + 16 * n2 + r) * 72 + 32 * ks + 8 * q);
#pragma unroll
                for (int mt = 0; mt < 4; ++mt) acc[mt][n2] = MFMA16(af[mt], bfr, acc[mt][n2]); }
        }
        if (tid < 64) { float s = 0.f;
#pragma unroll
            for (int c8 = 0; c8 < 8; ++c8) { const uint4 v = *(const uint4*)(P + tid * 72 + c8 * 8); float ff[8]; unpack8(v, ff);
#pragma unroll
                for (int e = 0; e < 8; ++e) s += ff[e]; }
            den += s; }
        __syncthreads();
    }
#undef ML2_GLOAD
#undef ML2_LSTORE
    const int ecol = h * 256 + 8 * (tid & 7);
    uint4 eo[4];
#pragma unroll
    for (int k = 0; k < 4; ++k) { const size_t idx = (size_t)(t0 + (tid >> 3)) * 2048 + ecol + 64 * k; eo[k] = *(const uint4*)(O + idx); }
    if (tid < 64) { den += __expf(mst - spm[tid]) * sqn[tid]; srd[tid] = 1.f / fmaxf(fabsf(den), __expf(-sam[tid])); }
    __syncthreads();
#pragma unroll
    for (int mt = 0; mt < 4; ++mt)
#pragma unroll
        for (int jj = 0; jj < 4; ++jj) { const int l = 16 * mt + 4 * q + jj; const float rd = srd[l];
            Ht[l * 260 + 32 * wave + r] = acc[mt][0][jj] * rd; Ht[l * 260 + 32 * wave + 16 + r] = acc[mt][1][jj] * rd; }
    __syncthreads();
    { const int l = tid >> 3, jx = tid & 7; float v[4][8]; float ss = 0.f;
#pragma unroll
      for (int k = 0; k < 4; ++k) { const float* hp = Ht + l * 260 + 8 * (jx + 8 * k); const float4 a0 = *(const float4*)hp, a1 = *(const float4*)(hp + 4);
          v[k][0] = a0.x; v[k][1] = a0.y; v[k][2] = a0.z; v[k][3] = a0.w; v[k][4] = a1.x; v[k][5] = a1.y; v[k][6] = a1.z; v[k][7] = a1.w;
#pragma unroll
          for (int e = 0; e < 8; ++e) ss += v[k][e] * v[k][e]; }
      ss += __shfl_xor(ss, 1); ss += __shfl_xor(ss, 2); ss += __shfl_xor(ss, 4);
      const float rstd = rsqrtf(ss * (1.f / 256.f) + EPSN);
      const float* nw = a.in[9];
#pragma unroll
      for (int k = 0; k < 4; ++k) { const int col = h * 256 + 8 * (jx + 8 * k); const size_t idx = (size_t)(t0 + l) * 2048 + col;
          float of[8]; unpack8(eo[k], of);
          const float4 n0 = *(const float4*)(nw + col), n1 = *(const float4*)(nw + col + 4);
          const float nwv[8] = {n0.x, n0.y, n0.z, n0.w, n1.x, n1.y, n1.z, n1.w};
          float y[8];
#pragma unroll
          for (int e = 0; e < 8; ++e) y[e] = of[e] * (v[k][e] * rstd * nwv[e]);
          *(uint4*)((u16*)(a.ws + OFF_YM) + idx) = pack8(y); } }
    __syncthreads();
}
__device__ __forceinline__ void ssd_pass2(const Args& a, unsigned char* smem, int g, int c) {
    const int tid = tid_opaque(), lane = tid & 63, wave = __builtin_amdgcn_readfirstlane(tid >> 6), r = lane & 15, q = lane >> 4;
    float* sS = (float*)smem; float* sa = (float*)(smem + 17408); float* sdt = (float*)(smem + 25600); float* Yt = (float*)smem;
    u16* Cs = (u16*)(smem + 33792); u16* Bs = (u16*)(smem + 51200); u16* XTs = (u16*)(smem + 68608);
    const u16* CC = (const u16*)(a.ws + OFF_CC); const u16* BC = (const u16*)(a.ws + OFF_BC); const u16* XT = (const u16*)(a.ws + OFF_XT);
    const u16* ZS = (const u16*)(a.ws + OFF_ZS);
    const int sc = c / RB, j = c % RB, t0 = c * 64, ts = sc * SUPT, hh = g * 8 + wave;
    const int bt = tid >> 4, bp = (tid & 15) * 8, xr = tid >> 3, xp = (tid & 7) * 8;
    uint4 b0, b1, x0, x1, x2, x3, x4, x5, x6, x7;
#define SS2_GLOAD(blk) do { const int tk0_ = ts + 64 * (blk); \
        b0 = *(const uint4*)(BC + (size_t)(tk0_ + bt) * 512 + g * 128 + bp); b1 = *(const uint4*)(BC + (size_t)(tk0_ + 32 + bt) * 512 + g * 128 + bp); \
        const u16* xb_ = XT + (size_t)(g * 512 + xr) * TP + tk0_ + xp; \
        x0 = *(const uint4*)(xb_); x1 = *(const uint4*)(xb_ + (size_t)64 * TP); x2 = *(const uint4*)(xb_ + (size_t)128 * TP); x3 = *(const uint4*)(xb_ + (size_t)192 * TP); \
        x4 = *(const uint4*)(xb_ + (size_t)256 * TP); x5 = *(const uint4*)(xb_ + (size_t)320 * TP); x6 = *(const uint4*)(xb_ + (size_t)384 * TP); x7 = *(const uint4*)(xb_ + (size_t)448 * TP); } while (0)
#define SS2_LSTORE() do { *(uint4*)(Bs + bt * 136 + bp) = b0; *(uint4*)(Bs + (32 + bt) * 136 + bp) = b1; u16* xd_ = XTs + xr * 72 + xp; \
        *(uint4*)(xd_) = x0; *(uint4*)(xd_ + 64 * 72) = x1; *(uint4*)(xd_ + 128 * 72) = x2; *(uint4*)(xd_ + 192 * 72) = x3; \
        *(uint4*)(xd_ + 256 * 72) = x4; *(uint4*)(xd_ + 320 * 72) = x5; *(uint4*)(xd_ + 384 * 72) = x6; *(uint4*)(xd_ + 448 * 72) = x7; } while (0)
    SS2_GLOAD(0);
    bf16x8 sfr[4][4];
    { const u16* Sg = (const u16*)(a.ws + OFF_SSB) + ((size_t)(hh * NSUP + sc) * 64) * 128 + (size_t)r * 128 + 8 * q;
#pragma unroll
      for (int nt = 0; nt < 4; ++nt)
#pragma unroll
          for (int ks = 0; ks < 4; ++ks) sfr[nt][ks] = LDFRAG(Sg + (size_t)(16 * nt) * 128 + 32 * ks); }
    { const uint4 c0 = *(const uint4*)(CC + (size_t)(t0 + bt) * 512 + g * 128 + bp), c1 = *(const uint4*)(CC + (size_t)(t0 + 32 + bt) * 512 + g * 128 + bp);
      *(uint4*)(Cs + bt * 136 + bp) = c0; *(uint4*)(Cs + (32 + bt) * 136 + bp) = c1; }
    { const float* scal = (const float*)(a.ws + OFF_SCAL);
      for (int blk = 0; blk <= j; ++blk) { const int t = ts + blk * 64 + lane;
          sa[wave * 256 + blk * 64 + lane] = scal[SC_SSA + hh * TS + t]; sdt[wave * 256 + blk * 64 + lane] = scal[SC_SSD + hh * TS + t]; } }
    __syncthreads();
    f32x4 acc[4][4];
#pragma unroll
    for (int i = 0; i < 4; ++i)
#pragma unroll
        for (int k = 0; k < 4; ++k) acc[i][k] = (f32x4){0.f, 0.f, 0.f, 0.f};
    {
#pragma unroll
      for (int ks = 0; ks < 4; ++ks) {
          bf16x8 af[4];
#pragma unroll
          for (int mt = 0; mt < 4; ++mt) af[mt] = *(const bf16x8*)(Cs + (16 * mt + r) * 136 + 32 * ks + 8 * q);
#pragma unroll
          for (int nt = 0; nt < 4; ++nt)
#pragma unroll
              for (int mt = 0; mt < 4; ++mt) acc[mt][nt] = MFMA16(af[mt], sfr[nt][ks], acc[mt][nt]);
      }
#pragma unroll
      for (int mt = 0; mt < 4; ++mt)
#pragma unroll
          for (int jj = 0; jj < 4; ++jj) { const float ea = __expf(sa[wave * 256 + j * 64 + 16 * mt + 4 * q + jj]);
#pragma unroll
              for (int nt = 0; nt < 4; ++nt) acc[mt][nt][jj] *= ea; } }
    const int mtS = wave >> 1;
#pragma unroll 1
    for (int i = 0; i <= j; ++i) {
        SS2_LSTORE();
        __syncthreads();
        if (i < j) SS2_GLOAD(i + 1);
        { f32x4 s2[2] = {(f32x4){0.f, 0.f, 0.f, 0.f}, (f32x4){0.f, 0.f, 0.f, 0.f}};
#pragma unroll
          for (int ks = 0; ks < 4; ++ks) { const bf16x8 cfr = *(const bf16x8*)(Cs + (16 * mtS + r) * 136 + 32 * ks + 8 * q);
#pragma unroll
              for (int u = 0; u < 2; ++u) s2[u] = MFMA16(cfr, *(const bf16x8*)(Bs + (16 * ((wave & 1) * 2 + u) + r) * 136 + 32 * ks + 8 * q), s2[u]); }
#pragma unroll
          for (int u = 0; u < 2; ++u)
#pragma unroll
              for (int jj = 0; jj < 4; ++jj) sS[(16 * mtS + 4 * q + jj) * 68 + 16 * ((wave & 1) * 2 + u) + r] = s2[u][jj]; }
        __syncthreads();
#pragma unroll
        for (int ks = 0; ks < 2; ++ks) {
            bf16x8 af[4];
            const int sb0 = 32 * ks + 8 * q;
            const float4 as0 = *(const float4*)(sa + wave * 256 + i * 64 + sb0), as1 = *(const float4*)(sa + wave * 256 + i * 64 + sb0 + 4);
            const float4 ds0 = *(const float4*)(sdt + wave * 256 + i * 64 + sb0), ds1 = *(const float4*)(sdt + wave * 256 + i * 64 + sb0 + 4);
            const float asv[8] = {as0.x, as0.y, as0.z, as0.w, as1.x, as1.y, as1.z, as1.w};
            const float dsv[8] = {ds0.x, ds0.y, ds0.z, ds0.w, ds1.x, ds1.y, ds1.z, ds1.w};
#pragma unroll
            for (int mt = 0; mt < 4; ++mt) { const int l = 16 * mt + r; const float al = sa[wave * 256 + j * 64 + l];
                const float4 v0 = *(const float4*)(sS + l * 68 + sb0), v1 = *(const float4*)(sS + l * 68 + sb0 + 4);
                const float sv[8] = {v0.x, v0.y, v0.z, v0.w, v1.x, v1.y, v1.z, v1.w};
                float mv[8];
#pragma unroll
                for (int e = 0; e < 8; ++e) { const bool ok = (i < j) || (sb0 + e <= l);
                    mv[e] = ok ? sv[e] * __expf(fminf(al - asv[e], 0.f)) * dsv[e] : 0.f; }
                const uint4 pk = pack8(mv);
                af[mt] = __builtin_bit_cast(bf16x8, pk); }
#pragma unroll
            for (int nt = 0; nt < 4; ++nt) { const bf16x8 xfr = *(const bf16x8*)(XTs + (wave * 64 + 16 * nt + r) * 72 + 32 * ks + 8 * q);
#pragma unroll
                for (int mt = 0; mt < 4; ++mt) acc[mt][nt] = MFMA16(af[mt], xfr, acc[mt][nt]); }
        }
        if (i < j) __syncthreads();
    }
#undef SS2_GLOAD
#undef SS2_LSTORE
    uint4 ezs[8];
#pragma unroll
    for (int k = 0; k < 8; ++k) ezs[k] = *(const uint4*)(ZS + (size_t)(t0 + (tid >> 3)) * 2048 + g * 512 + 8 * ((tid & 7) + 8 * k));
    { const float Dh = a.in[13][hh];
#pragma unroll
      for (int mt = 0; mt < 4; ++mt)
#pragma unroll
          for (int nt = 0; nt < 4; ++nt) { const uint2 xv = *(const uint2*)(XTs + (wave * 64 + 16 * nt + r) * 72 + 16 * mt + 4 * q);
              acc[mt][nt][0] += Dh * __uint_as_float(xv.x << 16); acc[mt][nt][1] += Dh * __uint_as_float(xv.x & 0xffff0000u);
              acc[mt][nt][2] += Dh * __uint_as_float(xv.y << 16); acc[mt][nt][3] += Dh * __uint_as_float(xv.y & 0xffff0000u); } }
    __syncthreads();
#pragma unroll
    for (int mt = 0; mt < 4; ++mt)
#pragma unroll
        for (int nt = 0; nt < 4; ++nt)
#pragma unroll
            for (int jj = 0; jj < 4; ++jj) Yt[(16 * mt + 4 * q + jj) * 516 + wave * 64 + 16 * nt + r] = acc[mt][nt][jj];
    __syncthreads();
    { const int l = tid >> 3, jx = tid & 7; float v[8][8]; float ss = 0.f;
      const u16* zrow = ZS + (size_t)(t0 + l) * 2048 + g * 512;
#pragma unroll
      for (int k = 0; k < 8; ++k) { const int pc = jx + 8 * k; const float* yp = Yt + l * 516 + 8 * pc; const float4 a0 = *(const float4*)yp, a1 = *(const float4*)(yp + 4);
          float zf[8]; unpack8(ezs[k], zf);
          v[k][0] = a0.x * zf[0]; v[k][1] = a0.y * zf[1]; v[k][2] = a0.z * zf[2]; v[k][3] = a0.w * zf[3];
          v[k][4] = a1.x * zf[4]; v[k][5] = a1.y * zf[5]; v[k][6] = a1.z * zf[6]; v[k][7] = a1.w * zf[7];
#pragma unroll
          for (int e = 0; e < 8; ++e) ss += v[k][e] * v[k][e]; }
      ss += __shfl_xor(ss, 1); ss += __shfl_xor(ss, 2); ss += __shfl_xor(ss, 4);
      const float rstd = rsqrtf(ss * (1.f / 512.f) + EPSN);
      const float* nw = a.in[14] + g * 512;
#pragma unroll
      for (int k = 0; k < 8; ++k) { const int pc = jx + 8 * k;
          const float4 n0 = *(const float4*)(nw + 8 * pc), n1 = *(const float4*)(nw + 8 * pc + 4);
          float y[8] = {v[k][0] * rstd * n0.x, v[k][1] * rstd * n0.y, v[k][2] * rstd * n0.z, v[k][3] * rstd * n0.w,
                        v[k][4] * rstd * n1.x, v[k][5] * rstd * n1.y, v[k][6] * rstd * n1.z, v[k][7] * rstd * n1.w};
          *(uint4*)((u16*)(a.ws + OFF_YS) + (size_t)(t0 + l) * 2048 + g * 512 + 8 * pc) = pack8(y); } }
    __syncthreads();
}

__device__ __forceinline__ void phase_final(const Args& a, int b) {
    const int tid = tid_opaque(), lane = tid & 63, wave = __builtin_amdgcn_readfirstlane(tid >> 6);
    const float* x = a.in[0]; const float* fw = a.in[18]; const float* gate = (const float*)(a.ws + OFF_MISC) + MI_MOD + b * 3072 + 2048;
    const u16* P1 = (const u16*)(a.ws + OFF_P1);
    for (int ml = blockIdx.x * 8 + wave; ml < TS; ml += gridDim.x * 8) {
        const size_t m = (size_t)b * TS + ml;
        const float4* xr = (const float4*)(x + m * DM) + lane; float4* orow = (float4*)(a.out + m * DM) + lane;
        const uint2* p0r = (const uint2*)(a.out + m * DM) + lane; const uint2* p1r = (const uint2*)(P1 + (size_t)ml * DM) + lane;
        float4 v[4]; float ss = 0.f;
#pragma unroll
        for (int j = 0; j < 4; ++j) { const float4 xv = xr[64 * j]; const uint2 q0 = p0r[64 * j], q1 = p1r[64 * j]; const float4 gt = *(const float4*)(gate + 4 * lane + 256 * j);
            const float s0 = __uint_as_float(q0.x << 16) + __uint_as_float(q1.x << 16), s1 = __uint_as_float(q0.x & 0xffff0000u) + __uint_as_float(q1.x & 0xffff0000u);
            const float s2 = __uint_as_float(q0.y << 16) + __uint_as_float(q1.y << 16), s3 = __uint_as_float(q0.y & 0xffff0000u) + __uint_as_float(q1.y & 0xffff0000u);
            v[j].x = xv.x + gt.x * s0; v[j].y = xv.y + gt.y * s1; v[j].z = xv.z + gt.z * s2; v[j].w = xv.w + gt.w * s3;
            ss += v[j].x * v[j].x + v[j].y * v[j].y + v[j].z * v[j].z + v[j].w * v[j].w; }
        const float rstd = rsqrtf(wave_sum(ss) * (1.f / DM) + EPSN);
#pragma unroll
        for (int j = 0; j < 4; ++j) { const float4 w = *(const float4*)(fw + 4 * lane + 256 * j);
            float4 o; o.x = v[j].x * rstd * w.x; o.y = v[j].y * rstd * w.y; o.z = v[j].z * rstd * w.z; o.w = v[j].w * rstd * w.w; orow[64 * j] = o; }
    }
}

#define XB_TMO      128
#define XB_XCNT(j)  (256  + 64 * (j))
#define XB_XSUB(j)  (1280 + 64 * (j))
#define XB_XGEN(j)  (2304 + 64 * (j))
#define XB_TOP      3328
#define XB_TOPGEN   3392
#define XCD_BAR_WORDS 3456
#define XB_SPIN_CAP (1u << 18)
#define LAS __attribute__((address_space(3)))

__device__ __forceinline__ unsigned xb_ld(unsigned* p)              { return __hip_atomic_load(p, __ATOMIC_RELAXED, __HIP_MEMORY_SCOPE_AGENT); }
__device__ __forceinline__ unsigned xb_add(unsigned* p, unsigned v) { return __hip_atomic_fetch_add(p, v, __ATOMIC_RELAXED, __HIP_MEMORY_SCOPE_AGENT); }
__device__ __forceinline__ unsigned xb_xcc_id() { return (unsigned)__builtin_amdgcn_s_getreg((3 << 11) | 20) & 0xFu; }
#define XB_SPIN(cond, bar) do { unsigned _sp = 0; while (cond) { __builtin_amdgcn_s_sleep(1); \
    if ((++_sp & 255u) == 0u) { if (xb_ld(&(bar)[XB_TMO])) break; if (_sp > XB_SPIN_CAP) { atomicAdd(&(bar)[XB_TMO], 1u); break; } } } } while (0)

struct XcdBarrier {
    unsigned* bar; unsigned x;
    volatile LAS unsigned* st;
};

__device__ __forceinline__ XcdBarrier xcd_barrier_post(unsigned* bar, volatile LAS unsigned* st) {
    XcdBarrier b; b.bar = bar; b.x = xb_xcc_id(); b.st = st;
    if (threadIdx.x == 0) (void)xb_add(&bar[XB_XCNT(b.x)], 1u);
    return b;
}
__device__ __forceinline__ void xcd_barrier_complete(unsigned* bar, unsigned x, unsigned& nloc, unsigned& nx) {
    const unsigned G = gridDim.x * gridDim.y * gridDim.z;
    unsigned sum, cnt, mine, sp = 0u;
    for (;;) {
        sum = 0u; cnt = 0u; mine = 0u;
#pragma unroll
        for (unsigned j = 0; j < 16; ++j) { const unsigned c = xb_ld(&bar[XB_XCNT(j)]); sum += c; cnt += (c > 0u) ? 1u : 0u; mine = (j == x) ? c : mine; }
        if (sum == G) break;
        __builtin_amdgcn_s_sleep(1);
        if ((++sp & 255u) == 0u) { if (xb_ld(&bar[XB_TMO])) break; if (sp > XB_SPIN_CAP) { atomicAdd(&bar[XB_TMO], 1u); break; } }
    }
    nloc = mine > 0u ? mine : 1u; nx = cnt > 0u ? cnt : 1u;
}

__device__ __forceinline__ void xcd_barrier(const XcdBarrier& b) {
    asm volatile("s_waitcnt vmcnt(0)" ::: "memory");
    __syncthreads();
    if (threadIdx.x == 0) {
        unsigned* bar = b.bar;
        __builtin_amdgcn_s_waitcnt(0);
        unsigned nloc = b.st[0], nx = b.st[1];
        if (nloc == 0u) { xcd_barrier_complete(bar, b.x, nloc, nx); b.st[0] = nloc; b.st[1] = nx; }
        const unsigned old = xb_add(&bar[XB_XSUB(b.x)], 1u);
        const unsigned gen = old / nloc;
        if (old + 1u == (gen + 1u) * nloc) {
            __builtin_amdgcn_fence(__ATOMIC_RELEASE, "agent");
            asm volatile("s_waitcnt vmcnt(0)" ::: "memory");
            const unsigned og = xb_add(&bar[XB_TOP], 1u);
            const unsigned tg = og / nx;
            if (og + 1u == (tg + 1u) * nx) xb_add(&bar[XB_TOPGEN], 1u);
            else XB_SPIN(xb_ld(&bar[XB_TOPGEN]) == tg, bar);
            __builtin_amdgcn_fence(__ATOMIC_ACQUIRE, "agent");
            xb_add(&bar[XB_XGEN(b.x)], 1u);
            asm volatile("s_waitcnt vmcnt(0)" ::: "memory");
        } else {
            XB_SPIN(xb_ld(&bar[XB_XGEN(b.x)]) == gen, bar);
            __builtin_amdgcn_fence(__ATOMIC_ACQUIRE, "agent");
            asm volatile("s_waitcnt vmcnt(0)" ::: "memory");
        }
    }
    __syncthreads();
}


constexpr int N_PHASES = 2 + 4 * 8;
__global__ void __launch_bounds__(512, 2) fwd(Args a) {
    extern __shared__ __attribute__((aligned(16))) unsigned char smem[];
    cg::grid_group grid = cg::this_grid();
    const int bid = blockIdx.x, G = gridDim.x;
    PG8_LAS unsigned char* lds = (PG8_LAS unsigned char*)smem;
    __shared__ uint4 xb_words;
    if (threadIdx.x == 0) xb_words = make_uint4(0u, 0u, 0u, 0u);
    __syncthreads();
    XcdBarrier xbar = xcd_barrier_post((unsigned*)(a.ws + OFF_BAR), (volatile LAS unsigned*)&xb_words);
    for (int ph = a.ph_lo; ph < a.ph_hi; ++ph) {
        bool need_sync = true;
        if (ph == 0) phase0(a, smem);
        else if (ph == 1) phase1(a);
        else {
            const int b = (ph - 2) / 8, k0_ = (ph - 2) % 8, k = (k0_ == 0) ? 0 : k0_ - 1;
#ifdef REP_K
            for (int rep_ = 0; rep_ < ((k0_ == REP_K) ? 2 : 1); ++rep_) { if (rep_) xcd_barrier(xbar);
#endif
            if (k0_ == 1) phase_conv(a); else
            if (k == 0) {
                pg8::Gemm g{(const pg8::bf16_t*)((unsigned char*)a.out + U_OFF_IN_OUT) + (size_t)b * TS * DM, (const pg8::bf16_t*)(a.ws + OFF_WIN), TS, NPAD, DM};
                pg8::StaticOrder S; S.init(TS, NPAD, G, bid);
                EpiProj E{a.ws, (const float*)(a.ws + OFF_MISC) + MI_BIAS};
                pg8::gemm_phase<EpiProj, pg8::StaticOrder, true, true>(lds, g, S, E);
            } else if (k == 1) {
                for (int it = bid; it < 512; it += G) {
                    if (it < 256) ml_pass1(a, smem, it & 7, it >> 3);
                    else { const int x = it - 256; ssd_pass1(a, smem, x & 3, x >> 3, (x >> 2) & 1); }
                }
            } else if (k == 2) phase_scan(a, smem);
            else if (k == 3) {
                for (int it = bid; it < 1536; it += G) {
#if defined(REP_K) && defined(REP_SUB)
                    if (rep_ && ((it < 1024) != (REP_SUB == 1))) continue;
#endif
                    if (it < 1024) { const int h = it & 7, cc = it >> 3, kk = (it >> 8) & 3; ml_pass2(a, smem, h, cc ^ kk); }
                    else { const int x = it - 1024, g = x & 3, cc = x >> 2, kk = (x >> 8) & 1; ssd_pass2(a, smem, g, cc ^ (kk * 3)); }
                }
            } else if (k == 4) {
                const int half = G >> 1, sel = (bid >= half) ? 1 : 0, c = bid - sel * half;
                if (c < half) {
                    pg8::Gemm g{(const pg8::bf16_t*)(a.ws + (sel ? OFF_YS : OFF_YM)), (const pg8::bf16_t*)(a.ws + (sel ? OFF_WS : OFF_WM)), TS, DM, 2048};
                    pg8::StaticOrder S; S.init(TS, DM, half, c);
                    EpiMerge E{(const u16*)(a.ws + OFF_MG), (u16*)(a.ws + (sel ? OFF_G1 : OFF_G0)), sel};
                    pg8::gemm_phase<EpiMerge, pg8::StaticOrder, true, true>(lds, g, S, E);
                }
            } else if (k == 5) {
                const int half = G >> 1, sel = (bid >= half) ? 1 : 0, c = bid - sel * half;
                if (c < half) {
                    pg8::Gemm g{(const pg8::bf16_t*)(a.ws + (sel ? OFF_G1 : OFF_G0)), (const pg8::bf16_t*)(a.ws + OFF_WO), TS, DM, DM};
                    pg8::StaticOrder S; S.init(TS, DM, half, c);
                    EpiOut E{sel ? (u16*)(a.ws + OFF_P1) : (u16*)(a.out + (size_t)b * TS * DM), sel ? 1024 : 2048};
                    pg8::gemm_phase<EpiOut, pg8::StaticOrder, true, true>(lds, g, S, E);
                }
            } else { phase_final(a, b); need_sync = false; }
#ifdef REP_K
            }
#endif
        }
        if (need_sync && ph + 1 < a.ph_hi) {
            if (a.ph_lo < 0) grid.sync();
            else xcd_barrier(xbar);
        }
    }
}

extern "C" void kernel_launch(void* const* d_in, const int* in_sizes, int n_in, void* d_out, int out_size, void* d_ws, size_t ws_size, hipStream_t stream) {
    static int grid = 0;
    if (grid == 0) {
        if (n_in != 19 || out_size != T_ALL * DM || ws_size < WS_END) { fprintf(stderr, "kernel_launch: unexpected shapes (n_in %d out %d ws %zu)\n", n_in, out_size, ws_size); grid = -1; return; }
        int dev = 0, cus = 0, per_cu = 0;
        hipGetDevice(&dev); hipDeviceGetAttribute(&cus, hipDeviceAttributeMultiprocessorCount, dev);
        hipFuncSetAttribute((const void*)fwd, hipFuncAttributeMaxDynamicSharedMemorySize, LDS_BYTES);
        hipOccupancyMaxActiveBlocksPerMultiprocessor(&per_cu, (const void*)fwd, 512, LDS_BYTES);
        if (per_cu < 1) { fprintf(stderr, "kernel_launch: occupancy query reports %d blocks per CU\n", per_cu); grid = -1; return; }
        grid = cus;
        if (grid & 1) grid -= 1;
    }
    if (grid < 0) return;
    Args a{};
    for (int i = 0; i < 19; ++i) a.in[i] = (const float*)d_in[i];
    a.out = (float*)d_out; a.ws = (unsigned char*)d_ws;
#if ONE_LAUNCH
    a.ph_lo = 0; a.ph_hi = N_PHASES;
    if (hipMemsetAsync((char*)d_ws + OFF_BAR, 0, XCD_BAR_WORDS_C * 4, stream) != hipSuccess) { fprintf(stderr, "kernel_launch: memset of the barrier words failed\n"); return; }
    void* args[] = {&a};
    hipError_t e = hipLaunchCooperativeKernel((const void*)fwd, dim3(grid), dim3(512), args, LDS_BYTES, stream);
    if (e != hipSuccess) fprintf(stderr, "cooperative launch failed: %s (grid %d)\n", hipGetErrorString(e), grid);
#else
    for (int ph = 0; ph < N_PHASES; ++ph) { a.ph_lo = ph; a.ph_hi = ph + 1; hipLaunchKernelGGL(fwd, dim3(grid), dim3(512), LDS_BYTES, stream, a); }
#endif
}
```

```cpp
#include <hip/hip_runtime.h>
#include <hip/hip_cooperative_groups.h>
#include <cstdio>
#include <cstdint>
namespace cg = cooperative_groups;
#ifndef ONE_LAUNCH
#define ONE_LAUNCH 1
#endif
namespace pg8 {
#define PG8_LAS __attribute__((address_space(3)))
typedef unsigned short bf16_t;
typedef short bf16x8 __attribute__((ext_vector_type(8)));
typedef float f32x4 __attribute__((ext_vector_type(4)));
typedef unsigned u32x4 __attribute__((ext_vector_type(4)));
constexpr int BM = 256, BK = 64, HALF = 128, HTB = HALF * BK * 2  , STAGE_BYTES = 8 * HTB, NXCD = 8, WGM = 8;

__host__ __device__ __forceinline__ int lds_byte(int r, int c) { const int st = (r >> 4) * 2 + (c >> 5), rr = r & 15, cc = c & 31, ob = rr * 64 + cc * 2; return st * 1024 + (ob ^ (((ob >> 9) & 1) << 5)); }
__host__ __device__ __forceinline__ void stage_rc(int b, int& R, int& C) { const int st = b / 1024, sb = b % 1024, swz = sb ^ (((sb >> 9) & 1) << 5); R = (st >> 1) * 16 + swz / 64; C = (st & 1) * 32 + (swz % 64) / 2; }
__host__ __device__ __forceinline__ int perm32(int rho) { const int n = rho >> 4, i = rho & 15; return 8 * (i >> 2) + 4 * n + (i & 3); }

struct Unit { int pm, pn; };
struct Gemm { const bf16_t* A; const bf16_t* Bt; int M, N, K; };

struct StaticOrder {
    int nM, nN, nwg, G, c;
    __host__ __device__ void init(int M, int N, int G_, int c_) { nM = M / BM; nN = N / BM; nwg = nM * nN; G = G_; c = c_; }
    __host__ __device__ bool next(int i, Unit& u) const {
        const long L = (long)i * G + c; if (L >= nwg) return false;
        int wgid = (int)L; { const int q = nwg / NXCD, r = nwg % NXCD, xcd = wgid % NXCD, off = wgid / NXCD; wgid = (xcd < r ? xcd * (q + 1) : r * (q + 1) + (xcd - r) * q) + off; }
        const int nig = WGM * nN, gid = wgid / nig, fm = gid * WGM, gsz = (nM - fm) < WGM ? (nM - fm) : WGM;
        u.pm = fm + ((wgid % nig) % gsz); u.pn = (wgid % nig) / gsz; return true;
    }
    __device__ __forceinline__ void a_ready(const Unit&) const {}
    __device__ __forceinline__ void done(const Unit&) const {}
};
template <class Epi, class Sched, bool ALIGN_EPI = false, bool SP2 = false>
__device__ __forceinline__ void gemm_phase(PG8_LAS unsigned char* lds, const Gemm g, const Sched& S, const Epi& E) {
    int tid = threadIdx.x; asm volatile("" : "+v"(tid)); const int wid = __builtin_amdgcn_readfirstlane(tid >> 6), lane = tid & 63, wr = wid >> 2, wc = wid & 3, fr = lane & 15, fq = lane >> 4;
    const int K = g.K, nt = K / BK;
    unsigned voffA[2], voffB[2];
#pragma unroll
    for (int i = 0; i < 2; ++i) { int R, C; stage_rc(tid * 16 + i * 8192, R, C); const int Rb = Epi::PERM ? ((R & ~31) + perm32(R & 31)) : R;
        voffA[i] = (unsigned)(R * K + C) * 2u; voffB[i] = (unsigned)(Rb * K + C) * 2u; }
    const size_t kstep = (size_t)(BK * 2);
    const size_t hstep = (size_t)HALF * K * 2;
    const size_t tstep = 2 * hstep;
    const unsigned ldsw = (unsigned)wid * 1024u;
    const int aoff = lds_byte(wr * 64 + fr, fq * 8), boff = lds_byte(wc * 32 + fr, fq * 8);
#define PG8_SA(b, h) (((b) * 2 + (h)) * HTB)
#define PG8_SB(b, h) ((4 + (b) * 2 + (h)) * HTB)
#define PG8_STAGE(bufoff, gbase, voff) do { _Pragma("unroll") for (int _i = 0; _i < 2; ++_i) \
        __builtin_amdgcn_global_load_lds((const unsigned*)((const char*)(gbase) + (voff)[_i]), (PG8_LAS unsigned*)(lds + (bufoff) + ldsw + _i * 8192), 16, 0, 0); } while (0)
#define PG8_LDA(dst, b, h) do { _Pragma("unroll") for (int m = 0; m < 4; ++m) _Pragma("unroll") for (int k = 0; k < 2; ++k) dst[m][k] = *(const PG8_LAS bf16x8*)(lds + PG8_SA(b, h) + aoff + m * 2048 + k * 1024); } while (0)
#define PG8_LDB(dst, b, h) do { _Pragma("unroll") for (int n = 0; n < 2; ++n) _Pragma("unroll") for (int k = 0; k < 2; ++k) dst[n][k] = *(const PG8_LAS bf16x8*)(lds + PG8_SB(b, h) + boff + n * 2048 + k * 1024); } while (0)
#define PG8_MMA(ai, bj, At, Bt) do { __builtin_amdgcn_s_setprio(1); _Pragma("unroll") for (int m = 0; m < 4; ++m) _Pragma("unroll") for (int n = 0; n < 2; ++n) _Pragma("unroll") for (int k = 0; k < 2; ++k) \
        acc[ai][bj][m][n] = __builtin_amdgcn_mfma_f32_16x16x32_bf16(Bt[n][k], At[m][k], acc[ai][bj][m][n], 0, 0, 0); __builtin_amdgcn_s_setprio(0); } while (0)
#define PG8_WAIT_V(n) asm volatile("s_waitcnt vmcnt(" #n ")" ::: "memory")
#define PG8_WAIT_L(n) asm volatile("s_waitcnt lgkmcnt(" #n ")" ::: "memory")
#define PG8_BAR __builtin_amdgcn_s_barrier()
#define PG8_SCHED __builtin_amdgcn_sched_barrier(0)
    Unit cur, nxt; int ui = 0;
    if (!S.next(0, cur)) return;
    f32x4 acc[2][2][4][2];
#pragma unroll
    for (int a = 0; a < 2; ++a)
#pragma unroll
        for (int b = 0; b < 2; ++b)
#pragma unroll
            for (int m = 0; m < 4; ++m)
#pragma unroll
                for (int n = 0; n < 2; ++n) acc[a][b][m][n] = (f32x4){0.f, 0.f, 0.f, 0.f};
    bf16x8 At[4][2], B0[2][2], B1[2][2];
    const char* cA = (const char*)g.A + (size_t)cur.pm * tstep; const char* cB = (const char*)g.Bt + (size_t)cur.pn * tstep;
    S.a_ready(cur);
    if constexpr (SP2) {
        PG8_STAGE(PG8_SB(0, 0), cB, voffB); PG8_STAGE(PG8_SB(0, 1), cB + hstep, voffB); PG8_STAGE(PG8_SA(0, 0), cA, voffA); PG8_STAGE(PG8_SA(0, 1), cA + hstep, voffA);
        if (wr == 1) PG8_BAR;
        PG8_WAIT_V(2); PG8_BAR;
        PG8_STAGE(PG8_SB(1, 0), cB + kstep, voffB); PG8_STAGE(PG8_SA(1, 0), cA + kstep, voffA); PG8_STAGE(PG8_SB(1, 1), cB + hstep + kstep, voffB);
        PG8_WAIT_V(6); PG8_BAR;
    } else {
        PG8_STAGE(PG8_SB(0, 0), cB, voffB); PG8_STAGE(PG8_SA(0, 0), cA, voffA); PG8_STAGE(PG8_SB(0, 1), cB + hstep, voffB); PG8_STAGE(PG8_SA(0, 1), cA + hstep, voffA);
        if (wr == 1) PG8_BAR;
        PG8_WAIT_V(4); PG8_BAR;
        PG8_STAGE(PG8_SB(1, 0), cB + kstep, voffB); PG8_STAGE(PG8_SA(1, 0), cA + kstep, voffA); PG8_STAGE(PG8_SB(1, 1), cB + hstep + kstep, voffB);
        PG8_WAIT_V(6); PG8_BAR;
    }
    for (;;) {
        const bool has_next = S.next(ui + 1, nxt);
        const char* nA = has_next ? (const char*)g.A + (size_t)nxt.pm * tstep : cA; const char* nB = has_next ? (const char*)g.Bt + (size_t)nxt.pn * tstep : cB;
        for (int t = 0; t < nt; t += 2) {
            const bool last = (t == nt - 2);
            const char* a1 = cA + (size_t)(t + 1) * kstep;
            const char* a2 = last ? nA : cA + (size_t)(t + 2) * kstep; const char* b2 = last ? nB : cB + (size_t)(t + 2) * kstep;
            const char* a3 = a2 + kstep; const char* b3 = b2 + kstep;
            if (last && has_next) S.a_ready(nxt);
            if constexpr (SP2) {
            PG8_LDB(B0, 0, 0); PG8_LDB(B1, 0, 1); PG8_SCHED; PG8_LDA(At, 0, 0); PG8_STAGE(PG8_SA(1, 1), a1 + hstep, voffA);
            PG8_WAIT_V(8); PG8_WAIT_L(0); PG8_BAR; PG8_MMA(0, 0, At, B0); PG8_MMA(0, 1, At, B1); PG8_BAR; PG8_SCHED;
            PG8_LDA(At, 0, 1); PG8_STAGE(PG8_SB(0, 0), b2, voffB); PG8_STAGE(PG8_SB(0, 1), b2 + hstep, voffB); PG8_STAGE(PG8_SA(0, 0), a2, voffA);
            PG8_WAIT_V(8); PG8_WAIT_L(0); PG8_BAR; PG8_MMA(1, 0, At, B0); PG8_MMA(1, 1, At, B1); PG8_BAR; PG8_SCHED;
            PG8_LDB(B0, 1, 0); PG8_LDB(B1, 1, 1); PG8_SCHED; PG8_LDA(At, 1, 0); PG8_STAGE(PG8_SA(0, 1), a2 + hstep, voffA);
            PG8_WAIT_V(8); PG8_WAIT_L(0); PG8_BAR; PG8_MMA(0, 0, At, B0); PG8_MMA(0, 1, At, B1); PG8_BAR; PG8_SCHED;
            PG8_LDA(At, 1, 1); PG8_STAGE(PG8_SB(1, 0), b3, voffB); PG8_STAGE(PG8_SB(1, 1), b3 + hstep, voffB); PG8_STAGE(PG8_SA(1, 0), a3, voffA);
            PG8_WAIT_V(8); PG8_WAIT_L(0); PG8_BAR; PG8_MMA(1, 0, At, B0); PG8_MMA(1, 1, At, B1); PG8_BAR; PG8_SCHED;
            } else {
            PG8_LDB(B0, 0, 0); PG8_SCHED; PG8_LDA(At, 0, 0); PG8_STAGE(PG8_SA(1, 1), a1 + hstep, voffA);
            PG8_WAIT_L(8); PG8_BAR; PG8_WAIT_L(0); PG8_MMA(0, 0, At, B0); PG8_BAR; PG8_SCHED;
            PG8_LDB(B1, 0, 1); PG8_STAGE(PG8_SB(0, 0), b2, voffB);
            PG8_BAR; PG8_WAIT_L(0); PG8_MMA(0, 1, At, B1); PG8_BAR;
            PG8_LDA(At, 0, 1); PG8_STAGE(PG8_SA(0, 0), a2, voffA);
            PG8_BAR; PG8_WAIT_L(0); PG8_MMA(1, 0, At, B0); PG8_BAR; PG8_SCHED;
            PG8_STAGE(PG8_SB(0, 1), b2 + hstep, voffB);
            PG8_WAIT_V(6); PG8_BAR; PG8_MMA(1, 1, At, B1); PG8_BAR;
            PG8_LDB(B0, 1, 0); PG8_SCHED; PG8_LDA(At, 1, 0); PG8_STAGE(PG8_SA(0, 1), a2 + hstep, voffA);
            PG8_WAIT_L(8); PG8_BAR; PG8_WAIT_L(0); PG8_MMA(0, 0, At, B0); PG8_BAR; PG8_SCHED;
            PG8_LDB(B1, 1, 1); PG8_STAGE(PG8_SB(1, 0), b3, voffB);
            PG8_BAR; PG8_WAIT_L(0); PG8_MMA(0, 1, At, B1); PG8_BAR;
            PG8_LDA(At, 1, 1); PG8_STAGE(PG8_SA(1, 0), a3, voffA);
            PG8_BAR; PG8_WAIT_L(0); PG8_MMA(1, 0, At, B0); PG8_BAR; PG8_SCHED;
            PG8_STAGE(PG8_SB(1, 1), b3 + hstep, voffB);
            PG8_WAIT_V(6); PG8_BAR; PG8_MMA(1, 1, At, B1); PG8_BAR;
            }
        }
        if constexpr (ALIGN_EPI) { if (wr == 0) PG8_BAR; }
        if constexpr (!Epi::AFTER_DRAIN) { E(acc, cur, wr, wc, fr, fq); S.done(cur); }
        if (!has_next) break;
#pragma unroll
        for (int a = 0; a < 2; ++a)
#pragma unroll
            for (int b = 0; b < 2; ++b)
#pragma unroll
                for (int m = 0; m < 4; ++m)
#pragma unroll
                    for (int n = 0; n < 2; ++n) acc[a][b][m][n] = (f32x4){0.f, 0.f, 0.f, 0.f};
        cur = nxt; cA = nA; cB = nB; ++ui;
        if constexpr (ALIGN_EPI) { if (wr == 1) PG8_BAR; }
    }
    PG8_WAIT_V(0);
    if constexpr (!ALIGN_EPI) { if (wr == 0) PG8_BAR; }
    PG8_BAR;
    if constexpr (Epi::AFTER_DRAIN) { E.fused(acc, cur, wr, wc, fr, fq, lds, wid, lane); S.done(cur); }
#undef PG8_SA
#undef PG8_SB
#undef PG8_STAGE
#undef PG8_LDA
#undef PG8_LDB
#undef PG8_MMA
#undef PG8_WAIT_V
#undef PG8_WAIT_L
#undef PG8_BAR
#undef PG8_SCHED
}
}

using pg8::bf16x8; using pg8::f32x4; using pg8::u32x4;
typedef unsigned short u16;

constexpr int T_ALL = 32768, DM = 1024, TS = 8192;
constexpr int NPAD = 15616, NIN = 15408;
constexpr int RB = 4, NSUP = 128 / RB, SUPT = 64 * RB;
constexpr size_t MiB = 1ull << 20;
constexpr float EPSN = 1e-6f;
constexpr size_t OFF_WIN = 0, OFF_WM = 32 * MiB, OFF_WS = 36 * MiB, OFF_WO = 40 * MiB, OFF_MISC = 42 * MiB;
constexpr size_t OFF_QK = 44 * MiB, OFF_V = 76 * MiB, OFF_XBC = 108 * MiB;
constexpr size_t OFF_MCD = 44 * MiB, OFF_SSD = 76 * MiB, OFF_MCB = 108 * MiB, OFF_SSB = 124 * MiB;
constexpr size_t OFF_G0 = 44 * MiB, OFF_G1 = 60 * MiB;
constexpr size_t OFF_O = 156 * MiB, OFF_ZM = 188 * MiB, OFF_ZS = 220 * MiB, OFF_MG = 252 * MiB, OFF_GF = 284 * MiB;
constexpr size_t OFF_QC = 292 * MiB, OFF_KC = 308 * MiB, OFF_KT = 324 * MiB, OFF_VT = 341 * MiB, OFF_XT = 374 * MiB, OFF_BC = 407 * MiB, OFF_BT = 415 * MiB, OFF_CC = 424 * MiB;
constexpr int TP = TS + 64;
constexpr size_t OFF_P1 = OFF_XT;
constexpr size_t OFF_SCAL = 432 * MiB, OFF_YM = 436 * MiB, OFF_YS = 468 * MiB, WS_END = 500 * MiB;
constexpr int SC_MLA = 0, SC_MLB = 65536, SC_MLP = 131072, SC_MLW = 196608, SC_SSA = 262144, SC_SSD = 524288, SC_SSW = 786432;
constexpr int MI_BIAS = 0, MI_MOD = 16384, MI_MATOT = 32768, MI_MMLOC = 33024, MI_MMST = 33280, MI_SATOT = 33536  , MI_MND = 36864  , MI_MNS = 69632  ;
constexpr size_t OFF_BAR = OFF_MISC + 1 * MiB;
constexpr size_t U_OFF_IN_OUT = 64 * MiB;
constexpr int LDS_BYTES = 147456;
constexpr int XCD_BAR_WORDS_C = 3456;

struct Args { const float* in[19]; float* out; unsigned char* ws; int ph_lo, ph_hi; };

__device__ __forceinline__ float bf2f(u16 b) { return __uint_as_float((unsigned)b << 16); }
__device__ __forceinline__ u16 f2bf(float f) { unsigned r; asm("v_cvt_pk_bf16_f32 %0, %1, %1" : "=v"(r) : "v"(f)); return (u16)r; }
__device__ __forceinline__ unsigned pk2(float lo, float hi) { unsigned r; asm("v_cvt_pk_bf16_f32 %0, %1, %2" : "=v"(r) : "v"(lo), "v"(hi)); return r; }
__device__ __forceinline__ float sigm(float x) { return __builtin_amdgcn_rcpf(1.f + __expf(-x)); }
__device__ __forceinline__ float silu(float x) { return x * __builtin_amdgcn_rcpf(1.f + __expf(-x)); }
__device__ __forceinline__ float softplus_(float x) { return fmaxf(x, 0.f) + log1pf(__expf(-fabsf(x))); }
__device__ __forceinline__ float logsig_(float x) { return fminf(x, 0.f) - log1pf(__expf(-fabsf(x))); }
__device__ __forceinline__ float wave_sum(float v) {
#pragma unroll
    for (int o = 1; o < 64; o <<= 1) v += __shfl_xor(v, o);
    return v;
}
__device__ __forceinline__ float wave_max(float v) {
#pragma unroll
    for (int o = 1; o < 64; o <<= 1) v = fmaxf(v, __shfl_xor(v, o));
    return v;
}
__device__ __forceinline__ float wave_scan_sum(float v, int lane) {
#pragma unroll
    for (int o = 1; o < 64; o <<= 1) { const float t = __shfl_up(v, o); if (lane >= o) v += t; }
    return v;
}
__device__ __forceinline__ float wave_scan_max(float v, int lane) {
#pragma unroll
    for (int o = 1; o < 64; o <<= 1) { const float t = __shfl_up(v, o); if (lane >= o) v = fmaxf(v, t); }
    return v;
}
__device__ __forceinline__ void unpack8(const uint4 v, float (&f)[8]) {
    f[0] = __uint_as_float(v.x << 16); f[1] = __uint_as_float(v.x & 0xffff0000u);
    f[2] = __uint_as_float(v.y << 16); f[3] = __uint_as_float(v.y & 0xffff0000u);
    f[4] = __uint_as_float(v.z << 16); f[5] = __uint_as_float(v.z & 0xffff0000u);
    f[6] = __uint_as_float(v.w << 16); f[7] = __uint_as_float(v.w & 0xffff0000u);
}
__device__ __forceinline__ uint4 pack8(const float (&f)[8]) { uint4 o; o.x = pk2(f[0], f[1]); o.y = pk2(f[2], f[3]); o.z = pk2(f[4], f[5]); o.w = pk2(f[6], f[7]); return o; }
__device__ __forceinline__ int tid_opaque() { int t = threadIdx.x; asm volatile("" : "+v"(t)); return t; }
__device__ __forceinline__ float gate2(float o, float z) { return z * __builtin_amdgcn_rcpf((1.f + __expf(-o)) * (1.f + __expf(-z))); }
#define MFMA16(a, b, c) __builtin_amdgcn_mfma_f32_16x16x32_bf16((a), (b), (c), 0, 0, 0)

__device__ __forceinline__ void conv8(const u16* src, int ld, int t, int col, const float* cw, const float* cb, int cstride, float (&o)[8]) {
    const float4 b0 = *(const float4*)(cb + col), b1 = *(const float4*)(cb + col + 4);
    float acc[8] = {b0.x, b0.y, b0.z, b0.w, b1.x, b1.y, b1.z, b1.w};
#pragma unroll
    for (int j = 0; j < 4; ++j) {
        const int tt = t - 3 + j;
        if (tt >= 0) {
            const uint4 v = *(const uint4*)(src + (size_t)tt * ld + col);
            const float4 w0 = *(const float4*)(cw + j * cstride + col), w1 = *(const float4*)(cw + j * cstride + col + 4);
            float x[8]; unpack8(v, x);
            acc[0] += x[0] * w0.x; acc[1] += x[1] * w0.y; acc[2] += x[2] * w0.z; acc[3] += x[3] * w0.w;
            acc[4] += x[4] * w1.x; acc[5] += x[5] * w1.y; acc[6] += x[6] * w1.z; acc[7] += x[7] * w1.w;
        }
    }
#pragma unroll
    for (int e = 0; e < 8; ++e) o[e] = silu(acc[e]);
}

__host__ __device__ __forceinline__ int srccol(int n) {
    if (n < 4096) return n;
    if (n < 8192) { const int t = (n - 4096) >> 8, c = (n - 4096) & 255; return c < 128 ? 4096 + 128 * t + c : 6144 + 128 * t + (c - 128); }
    if (n < 13312) return n + 16;
    if (n < 15360) return n + 48;
    if (n < 15376) return 8192 + (n - 15360);
    if (n < 15408) return 13328 + (n - 15376);
    return -1;
}

__device__ __forceinline__ void tr_item(const float* W, int K, int N, int NOUT, u16* WT, float* scr, int item, int lane, bool remap) {
    const int nblk = NOUT / 32, kb = item / nblk, nb = item % nblk, k0 = 64 * kb, n0 = 32 * nb;
    const int c4 = lane & 7, kr = lane >> 3;
    int src = n0 + 4 * c4; if (remap) src = srccol(src);
    float4 v[8];
#pragma unroll
    for (int i = 0; i < 8; ++i) v[i] = (src >= 0) ? *(const float4*)(W + (size_t)(k0 + 8 * i + kr) * N + src) : make_float4(0.f, 0.f, 0.f, 0.f);
#pragma unroll
    for (int i = 0; i < 8; ++i) { float* d = scr + (8 * i + kr) * 33 + 4 * c4; d[0] = v[i].x; d[1] = v[i].y; d[2] = v[i].z; d[3] = v[i].w; }
    asm volatile("s_waitcnt lgkmcnt(0)" ::: "memory");
    const int c = lane & 7;
#pragma unroll
    for (int j = 0; j < 4; ++j) { const int n = (lane >> 3) + 8 * j; const float* s = scr + (8 * c) * 33 + n;
        uint4 o; o.x = pk2(s[0 * 33], s[1 * 33]); o.y = pk2(s[2 * 33], s[3 * 33]); o.z = pk2(s[4 * 33], s[5 * 33]); o.w = pk2(s[6 * 33], s[7 * 33]);
        *(uint4*)(WT + (size_t)(n0 + n) * K + k0 + 8 * c) = o; }
    asm volatile("s_waitcnt lgkmcnt(0)" ::: "memory");
}
__device__ __forceinline__ void phase0(const Args& a, unsigned char* smem) {
    const int tid = tid_opaque(), lane = tid & 63, wave = __builtin_amdgcn_readfirstlane(tid >> 6), bid = blockIdx.x, G = gridDim.x;
    const float* cvec = a.in[1]; const float* ada_w = a.in[3]; const float* ada_b = a.in[4];
    float* misc = (float*)(a.ws + OFF_MISC);
    float* scv = (float*)smem; float* red = (float*)(smem + 16384);
    for (int i = tid; i < 4096; i += 512) scv[i] = silu(cvec[i]);
    __syncthreads();
    for (int cgp = bid; cgp < 256; cgp += G) {
        const int jj = tid & 15, kq = tid >> 4;
        float s0 = 0.f, s1 = 0.f, s2 = 0.f, s3 = 0.f;
        if (jj < 12) {
            const int j = cgp * 12 + jj;
#pragma unroll 8
            for (int k = kq; k < 1024; k += 32) {
                const float w = ada_w[(size_t)k * 3072 + j];
                s0 += scv[k] * w; s1 += scv[1024 + k] * w; s2 += scv[2048 + k] * w; s3 += scv[3072 + k] * w;
            }
        }
        red[(kq * 16 + jj) * 4 + 0] = s0; red[(kq * 16 + jj) * 4 + 1] = s1; red[(kq * 16 + jj) * 4 + 2] = s2; red[(kq * 16 + jj) * 4 + 3] = s3;
        __syncthreads();
        if (tid < 48) { const int j2 = tid % 12, bb = tid / 12; float s = 0.f; for (int k2 = 0; k2 < 32; ++k2) s += red[(k2 * 16 + j2) * 4 + bb];
            const int j = cgp * 12 + j2; misc[MI_MOD + bb * 3072 + j] = s + ada_b[j]; }
        __syncthreads();
    }
    float* scr = (float*)(smem + 24576 + wave * 8448);
    const int gw = bid * 8 + wave, NGW = G * 8;
    constexpr int I_IN = 16 * (NPAD / 32), I_M = 32 * 32, I_O = 16 * 32;
    for (int it = gw; it < I_IN + 2 * I_M + I_O; it += NGW) {
        int r = it;
        if (r < I_IN) { tr_item(a.in[5], 1024, NIN, NPAD, (u16*)(a.ws + OFF_WIN), scr, r, lane, true); continue; } r -= I_IN;
        if (r < I_M) { tr_item(a.in[15], 2048, 1024, 1024, (u16*)(a.ws + OFF_WM), scr, r, lane, false); continue; } r -= I_M;
        if (r < I_M) { tr_item(a.in[16], 2048, 1024, 1024, (u16*)(a.ws + OFF_WS), scr, r, lane, false); continue; } r -= I_M;
        tr_item(a.in[17], 1024, 1024, 1024, (u16*)(a.ws + OFF_WO), scr, r, lane, false);
    }
    for (int n = bid * 512 + tid; n < NPAD; n += G * 512) { const int s = srccol(n); misc[MI_BIAS + n] = (s >= 0) ? a.in[6][s] : 0.f; }
}

__device__ __forceinline__ void phase1(const Args& a) {
    const int tid = tid_opaque(), lane = tid & 63, wave = __builtin_amdgcn_readfirstlane(tid >> 6);
    const float* x = a.in[0]; const float* nw = a.in[2]; const float* mod = (const float*)(a.ws + OFF_MISC) + MI_MOD;
    u16* U = (u16*)((unsigned char*)a.out + U_OFF_IN_OUT);
    for (int m = blockIdx.x * 8 + wave; m < T_ALL; m += gridDim.x * 8) {
        const float4* xr = (const float4*)(x + (size_t)m * DM) + lane;
        float4 v[4]; float ss = 0.f;
#pragma unroll
        for (int j = 0; j < 4; ++j) { v[j] = xr[64 * j]; ss += v[j].x * v[j].x + v[j].y * v[j].y + v[j].z * v[j].z + v[j].w * v[j].w; }
        const float rstd = rsqrtf(wave_sum(ss) * (1.f / DM) + EPSN);
        const int b = m / TS;
#pragma unroll
        for (int j = 0; j < 4; ++j) {
            const int col = 4 * lane + 256 * j;
            const float4 w = *(const float4*)(nw + col), sh = *(const float4*)(mod + b * 3072 + col), sc = *(const float4*)(mod + b * 3072 + 1024 + col);
            const float u0 = (v[j].x * rstd * w.x) * (1.f + sc.x) + sh.x, u1 = (v[j].y * rstd * w.y) * (1.f + sc.y) + sh.y;
            const float u2 = (v[j].z * rstd * w.z) * (1.f + sc.z) + sh.z, u3 = (v[j].w * rstd * w.w) * (1.f + sc.w) + sh.w;
            uint2 o; o.x = pk2(u0, u1); o.y = pk2(u2, u3);
            *(uint2*)(U + (size_t)m * DM + col) = o;
        }
    }
}

struct EpiProj {
    static constexpr bool PERM = true, AFTER_DRAIN = false;
    unsigned char* ws; const float* bias;
    __device__ __forceinline__ void operator()(const f32x4 (&acc)[2][2][4][2], const pg8::Unit& u, int wr, int wc, int fr, int fq) const {
        const int row0 = u.pm * 256 + wr * 64 + fr, pn = u.pn;
        const float* bp = bias + pn * 256 + wc * 32 + 8 * fq;
        if (pn >= 8 && pn < 16) {
            u16* vt = (u16*)(ws + OFF_VT) + (size_t)((pn - 8) * 256 + wc * 32 + 8 * fq) * TP + row0;
#pragma unroll
            for (int bj = 0; bj < 2; ++bj) {
                const f32x4 b0 = *(const f32x4*)(bp + bj * 128), b1 = *(const f32x4*)(bp + bj * 128 + 4);
#pragma unroll
                for (int ai = 0; ai < 2; ++ai)
#pragma unroll
                    for (int m = 0; m < 4; ++m) { const f32x4 v0 = acc[ai][bj][m][0] + b0, v1 = acc[ai][bj][m][1] + b1;
                        u16* d = vt + (size_t)(bj * 128) * TP + ai * 128 + m * 16;
                        d[0] = f2bf(v0[0]); d[(size_t)TP] = f2bf(v0[1]); d[(size_t)2 * TP] = f2bf(v0[2]); d[(size_t)3 * TP] = f2bf(v0[3]);
                        d[(size_t)4 * TP] = f2bf(v1[0]); d[(size_t)5 * TP] = f2bf(v1[1]); d[(size_t)6 * TP] = f2bf(v1[2]); d[(size_t)7 * TP] = f2bf(v1[3]); }
            }
        } else if (pn >= 16 && pn < 32) {
            u16* gp = (u16*)(ws + OFF_O) + (size_t)row0 * 2048 + (pn - 16) * 128 + wc * 32 + 8 * fq;
            const f32x4 bo0 = *(const f32x4*)(bp), bo1 = *(const f32x4*)(bp + 4), bz0 = *(const f32x4*)(bp + 128), bz1 = *(const f32x4*)(bp + 132);
#pragma unroll
            for (int ai = 0; ai < 2; ++ai)
#pragma unroll
                for (int m = 0; m < 4; ++m) { const f32x4 o0 = acc[ai][0][m][0] + bo0, o1 = acc[ai][0][m][1] + bo1, z0 = acc[ai][1][m][0] + bz0, z1 = acc[ai][1][m][1] + bz1;
                    u32x4 w; w.x = pk2(gate2(o0[0], z0[0]), gate2(o0[1], z0[1])); w.y = pk2(gate2(o0[2], z0[2]), gate2(o0[3], z0[3]));
                    w.z = pk2(gate2(o1[0], z1[0]), gate2(o1[1], z1[1])); w.w = pk2(gate2(o1[2], z1[2]), gate2(o1[3], z1[3]));
                    *(u32x4*)(gp + (size_t)(ai * 128 + m * 16) * 2048) = w; }
        } else if (pn < 60) {
            u16* base; int ldc, ct;
            if (pn < 32) { const int sg = pn >> 3; base = (u16*)(ws + (sg < 2 ? OFF_QK + (size_t)sg * (32 * MiB) : OFF_O + (size_t)(sg - 2) * (32 * MiB))); ldc = 2048; ct = pn & 7; }
            else if (pn < 44) { base = (u16*)(ws + OFF_XBC); ldc = 3072; ct = pn - 32; }
            else { base = (u16*)(ws + OFF_ZS + (size_t)((pn - 44) >> 3) * (32 * MiB)); ldc = 2048; ct = (pn - 44) & 7; }
            u16* p0 = base + (size_t)row0 * ldc + ct * 256 + wc * 32 + 8 * fq;
            const int act_ = (pn >= 52) ? 2 : ((pn >= 44) ? 1 : 0);
#pragma unroll
            for (int bj = 0; bj < 2; ++bj) {
                const f32x4 b0 = *(const f32x4*)(bp + bj * 128), b1 = *(const f32x4*)(bp + bj * 128 + 4);
#pragma unroll
                for (int ai = 0; ai < 2; ++ai)
#pragma unroll
                    for (int m = 0; m < 4; ++m) { f32x4 v0 = acc[ai][bj][m][0] + b0, v1 = acc[ai][bj][m][1] + b1;
                        if (act_ == 1) {
#pragma unroll
                            for (int e = 0; e < 4; ++e) { v0[e] = silu(v0[e]); v1[e] = silu(v1[e]); } }
                        else if (act_ == 2) {
#pragma unroll
                            for (int e = 0; e < 4; ++e) { v0[e] = sigm(v0[e]); v1[e] = sigm(v1[e]); } }
                        u32x4 w; w.x = pk2(v0[0], v0[1]); w.y = pk2(v0[2], v0[3]); w.z = pk2(v1[0], v1[1]); w.w = pk2(v1[2], v1[3]);
                        *(u32x4*)(p0 + (size_t)(ai * 128 + m * 16) * ldc + bj * 128) = w; }
            }
        } else {
            float* p0 = (float*)(ws + OFF_GF) + (size_t)row0 * 256 + wc * 32 + 8 * fq;
            const f32x4 b0 = *(const f32x4*)(bp), b1 = *(const f32x4*)(bp + 4);
#pragma unroll
            for (int ai = 0; ai < 2; ++ai)
#pragma unroll
                for (int m = 0; m < 4; ++m) { float* rowp = p0 + (size_t)(ai * 128 + m * 16) * 256;
                    *(f32x4*)(rowp) = acc[ai][0][m][0] + b0; *(f32x4*)(rowp + 4) = acc[ai][0][m][1] + b1; }
        }
    }
};
struct EpiMerge {
    static constexpr bool PERM = true, AFTER_DRAIN = false;
    const u16* mg; u16* G; int sel;
    __device__ __forceinline__ void operator()(const f32x4 (&acc)[2][2][4][2], const pg8::Unit& u, int wr, int wc, int fr, int fq) const {
        const int row0 = u.pm * 256 + wr * 64 + fr, col0 = u.pn * 256 + wc * 32 + 8 * fq;
#pragma unroll
        for (int ai = 0; ai < 2; ++ai)
#pragma unroll
            for (int m = 0; m < 4; ++m) { const int row = row0 + ai * 128 + m * 16;
#pragma unroll
                for (int bj = 0; bj < 2; ++bj) { const int col = col0 + bj * 128;
                    const uint4 gq = *(const uint4*)(mg + (size_t)row * 2048 + sel * 1024 + col); float g[8]; unpack8(gq, g);
                    const f32x4 a0 = acc[ai][bj][m][0], a1 = acc[ai][bj][m][1];
                    u32x4 w; w.x = pk2(a0[0] * g[0], a0[1] * g[1]); w.y = pk2(a0[2] * g[2], a0[3] * g[3]);
                    w.z = pk2(a1[0] * g[4], a1[1] * g[5]); w.w = pk2(a1[2] * g[6], a1[3] * g[7]);
                    *(u32x4*)(G + (size_t)row * 1024 + col) = w; } }
    }
};
struct EpiOut {
    static constexpr bool PERM = true, AFTER_DRAIN = false;
    u16* C; int ldc;
    __device__ __forceinline__ void operator()(const f32x4 (&acc)[2][2][4][2], const pg8::Unit& u, int wr, int wc, int fr, int fq) const {
        const int row0 = u.pm * 256 + wr * 64 + fr, col0 = u.pn * 256 + wc * 32 + 8 * fq;
#pragma unroll
        for (int ai = 0; ai < 2; ++ai)
#pragma unroll
            for (int m = 0; m < 4; ++m) { u16* rowp = C + (size_t)(row0 + ai * 128 + m * 16) * ldc + col0;
#pragma unroll
                for (int bj = 0; bj < 2; ++bj) { const f32x4 v0 = acc[ai][bj][m][0], v1 = acc[ai][bj][m][1];
                    u32x4 w; w.x = pk2(v0[0], v0[1]); w.y = pk2(v0[2], v0[3]); w.z = pk2(v1[0], v1[1]); w.w = pk2(v1[2], v1[3]);
                    *(u32x4*)(rowp + bj * 128) = w; } }
    }
};

__device__ __forceinline__ unsigned lo16pair(unsigned a, unsigned b) { return (a & 0xffffu) | (b << 16); }
__device__ __forceinline__ unsigned hi16pair(unsigned a, unsigned b) { return (a >> 16) | (b & 0xffff0000u); }
__device__ __forceinline__ unsigned u4w(const uint4& v, int w) { return w == 0 ? v.x : (w == 1 ? v.y : (w == 2 ? v.z : v.w)); }
__device__ __forceinline__ void store_transposed(const uint4 (&pk)[8], u16* T, int row0, int tcol) {
#pragma unroll
    for (int e = 0; e < 8; ++e) {
        const int w = e >> 1; uint4 o;
        if ((e & 1) == 0) { o.x = lo16pair(u4w(pk[0], w), u4w(pk[1], w)); o.y = lo16pair(u4w(pk[2], w), u4w(pk[3], w)); o.z = lo16pair(u4w(pk[4], w), u4w(pk[5], w)); o.w = lo16pair(u4w(pk[6], w), u4w(pk[7], w)); }
        else { o.x = hi16pair(u4w(pk[0], w), u4w(pk[1], w)); o.y = hi16pair(u4w(pk[2], w), u4w(pk[3], w)); o.z = hi16pair(u4w(pk[4], w), u4w(pk[5], w)); o.w = hi16pair(u4w(pk[6], w), u4w(pk[7], w)); }
        *(uint4*)(T + (size_t)(row0 + e) * TP + tcol) = o;
    }
}
__device__ __forceinline__ void phase_conv(const Args& a) {
    const int tid = tid_opaque(), lane = tid & 63, wave = __builtin_amdgcn_readfirstlane(tid >> 6);
    const int piece = lane & 7, tg = lane >> 3;
    const int gw = blockIdx.x * 8 + wave, NGW = gridDim.x * 8;
    float* misc = (float*)(a.ws + OFF_MISC); float* scal = (float*)(a.ws + OFF_SCAL); const float* GF = (const float*)(a.ws + OFF_GF);
    const bool even_ = (gridDim.x == 256);
    for (int task = even_ ? ((wave < 5) ? (int)blockIdx.x * 5 + wave : 1280) : gw; task < 1280; task += even_ ? 1280 : NGW) {
        if (task < 256) {
            const int h = task & 7, sc = task >> 3, ts = sc * SUPT;
            float fp[RB], ip[RB];
#pragma unroll
            for (int blk = 0; blk < RB; ++blk) { const int t = ts + blk * 64 + lane; fp[blk] = GF[(size_t)t * 256 + 8 + h]; ip[blk] = GF[(size_t)t * 256 + h]; }
            float carry = 0.f, pm = -3.0e38f, bv[RB];
#pragma unroll
            for (int blk = 0; blk < RB; ++blk) { const int t = ts + blk * 64 + lane;
                const float av = wave_scan_sum(logsig_(fp[blk]), lane) + carry; carry = __shfl(av, 63);
                const float b = ip[blk] - av; bv[blk] = b;
                const float plm = fmaxf(wave_scan_max(b, lane), pm); pm = __shfl(plm, 63);
                scal[SC_MLA + h * TS + t] = av; scal[SC_MLB + h * TS + t] = b; scal[SC_MLP + h * TS + t] = plm; }
#pragma unroll
            for (int blk = 0; blk < RB; ++blk) scal[SC_MLW + h * TS + ts + blk * 64 + lane] = __expf(bv[blk] - pm);
            if (lane == 0) { misc[MI_MATOT + h * NSUP + sc] = carry; misc[MI_MMLOC + h * NSUP + sc] = carry + pm; }
        } else {
            const int x = task - 256, hh = x & 31, sc = x >> 5, ts = sc * SUPT;
            const float Ah = -__expf(a.in[12][hh]);
            float dtr[RB];
#pragma unroll
            for (int blk = 0; blk < RB; ++blk) dtr[blk] = GF[(size_t)(ts + blk * 64 + lane) * 256 + 16 + hh];
            float carry = 0.f, av[RB], dv[RB];
#pragma unroll
            for (int blk = 0; blk < RB; ++blk) { const int t = ts + blk * 64 + lane;
                const float dt = softplus_(dtr[blk]);
                av[blk] = wave_scan_sum(dt * Ah, lane) + carry; carry = __shfl(av[blk], 63); dv[blk] = dt;
                scal[SC_SSA + hh * TS + t] = av[blk]; scal[SC_SSD + hh * TS + t] = dt; }
#pragma unroll
            for (int blk = 0; blk < RB; ++blk) scal[SC_SSW + hh * TS + ts + blk * 64 + lane] = __expf(carry - av[blk]) * dv[blk];
            if (lane == 0) misc[MI_SATOT + hh * NSUP + sc] = carry;
        }
    }
    for (int wt = gw; wt < 112 * 128; wt += NGW) {
        const int gidx = wt >> 7, tb = wt & 127, t0 = tb * 64 + 8 * tg;
        if (gidx >= 32 && gidx < 64) continue;
        if (false) {
            const int col = (gidx - 32) * 64 + piece * 8;
            const u16* V = (const u16*)(a.ws + OFF_V);
            uint4 pk[8];
#pragma unroll
            for (int i = 0; i < 8; ++i) pk[i] = *(const uint4*)(V + (size_t)(t0 + i) * 2048 + col);
            store_transposed(pk, (u16*)(a.ws + OFF_VT), col, t0);
            continue;
        }
        const u16* src; int ld, scol; const float* cw; const float* cb; int cstride;
        u16* rowdst = nullptr; int rld = 0, rcol = 0; u16* trdst = nullptr; int trow = 0; float scale = 1.f;
        if (gidx < 16) { src = (const u16*)(a.ws + OFF_QK); ld = 2048; scol = gidx * 64; cw = a.in[7]; cb = a.in[8]; cstride = 2048;
            rowdst = (u16*)(a.ws + OFF_QC); rld = 1024; rcol = gidx * 64; scale = 0.08838834764831845f; }
        else if (gidx < 32) { src = (const u16*)(a.ws + OFF_QK); ld = 2048; scol = 1024 + (gidx - 16) * 64; cw = a.in[7]; cb = a.in[8]; cstride = 2048;
            rowdst = (u16*)(a.ws + OFF_KC); rld = 1024; rcol = (gidx - 16) * 64; trdst = (u16*)(a.ws + OFF_KT); trow = (gidx - 16) * 64; }
        else if (gidx < 96) { src = (const u16*)(a.ws + OFF_XBC); ld = 3072; scol = (gidx - 64) * 64; cw = a.in[10]; cb = a.in[11]; cstride = 3072;
            trdst = (u16*)(a.ws + OFF_XT); trow = (gidx - 64) * 64; }
        else if (gidx < 104) { src = (const u16*)(a.ws + OFF_XBC); ld = 3072; scol = 2048 + (gidx - 96) * 64; cw = a.in[10]; cb = a.in[11]; cstride = 3072;
            rowdst = (u16*)(a.ws + OFF_BC); rld = 512; rcol = (gidx - 96) * 64; trdst = (u16*)(a.ws + OFF_BT); trow = (gidx - 96) * 64; }
        else { src = (const u16*)(a.ws + OFF_XBC); ld = 3072; scol = 2560 + (gidx - 104) * 64; cw = a.in[10]; cb = a.in[11]; cstride = 3072;
            rowdst = (u16*)(a.ws + OFF_CC); rld = 512; rcol = (gidx - 104) * 64; }
        const int col = scol + piece * 8;
        uint4 raw[11];
#pragma unroll
        for (int i = 0; i < 11; ++i) { const int tt = t0 - 3 + i; raw[i] = (tt >= 0) ? *(const uint4*)(src + (size_t)tt * ld + col) : make_uint4(0u, 0u, 0u, 0u); }
        float w[4][8], bs[8];
#pragma unroll
        for (int j = 0; j < 4; ++j) { const float4 w0 = *(const float4*)(cw + j * cstride + col), w1 = *(const float4*)(cw + j * cstride + col + 4);
            w[j][0] = w0.x; w[j][1] = w0.y; w[j][2] = w0.z; w[j][3] = w0.w; w[j][4] = w1.x; w[j][5] = w1.y; w[j][6] = w1.z; w[j][7] = w1.w; }
        { const float4 b0 = *(const float4*)(cb + col), b1 = *(const float4*)(cb + col + 4);
          bs[0] = b0.x; bs[1] = b0.y; bs[2] = b0.z; bs[3] = b0.w; bs[4] = b1.x; bs[5] = b1.y; bs[6] = b1.z; bs[7] = b1.w; }
        uint4 pk[8];
#pragma unroll
        for (int i = 0; i < 8; ++i) {
            float acc[8];
#pragma unroll
            for (int e = 0; e < 8; ++e) acc[e] = bs[e];
#pragma unroll
            for (int j = 0; j < 4; ++j) { float x[8]; unpack8(raw[i + j], x);
#pragma unroll
                for (int e = 0; e < 8; ++e) acc[e] += x[e] * w[j][e]; }
#pragma unroll
            for (int e = 0; e < 8; ++e) acc[e] = silu(acc[e]) * scale;
            pk[i] = pack8(acc);
            if (rowdst) *(uint4*)(rowdst + (size_t)(t0 + i) * rld + rcol + piece * 8) = pk[i];
        }
        if (trdst) store_transposed(pk, trdst, trow + piece * 8, t0);
    }
}

__device__ __forceinline__ bf16x8 scale_frag(const uint4 v, const float4 w0, const float4 w1) {
    float f[8]; unpack8(v, f);
    f[0] *= w0.x; f[1] *= w0.y; f[2] *= w0.z; f[3] *= w0.w; f[4] *= w1.x; f[5] *= w1.y; f[6] *= w1.z; f[7] *= w1.w;
    const uint4 p = pack8(f); return __builtin_bit_cast(bf16x8, p);
}
#define LDFRAG(ptr) (*(const bf16x8*)(ptr))

#define P1_GLOAD(blk) do { const int tk0_ = ts + 64 * (blk); \
        ar0 = *(const uint4*)(Abase + (size_t)(srow) * TP + tk0_ + spc); ar1 = *(const uint4*)(Abase + (size_t)(64 + srow) * TP + tk0_ + spc); \
        ar2 = *(const uint4*)(Abase + (size_t)(128 + srow) * TP + tk0_ + spc); ar3 = *(const uint4*)(Abase + (size_t)(192 + srow) * TP + tk0_ + spc); \
        br0 = *(const uint4*)(Bbase + (size_t)(srow) * TP + tk0_ + spc); br1 = *(const uint4*)(Bbase + (size_t)(64 + srow) * TP + tk0_ + spc); } while (0)
#define P1_LSTORE(stage) do { u16* As_ = (u16*)(smem + (stage) * 55296); u16* Bs_ = As_ + 18432; \
        *(uint4*)(As_ + srow * 72 + spc) = ar0; *(uint4*)(As_ + (64 + srow) * 72 + spc) = ar1; *(uint4*)(As_ + (128 + srow) * 72 + spc) = ar2; *(uint4*)(As_ + (192 + srow) * 72 + spc) = ar3; \
        *(uint4*)(Bs_ + srow * 72 + spc) = br0; *(uint4*)(Bs_ + (64 + srow) * 72 + spc) = br1; } while (0)
__device__ __forceinline__ void ml_pass1(const Args& a, unsigned char* smem, int h, int sc) {
    const int tid = tid_opaque(), lane = tid & 63, wave = __builtin_amdgcn_readfirstlane(tid >> 6), r = lane & 15, q = lane >> 4;
    const u16* KT = (const u16*)(a.ws + OFF_KT); const u16* VT = (const u16*)(a.ws + OFF_VT);
    float* misc = (float*)(a.ws + OFF_MISC);
    const int ts = sc * SUPT, srow = tid >> 3, spc = (tid & 7) * 8;
    const float* wkp = (const float*)(a.ws + OFF_SCAL) + SC_MLW + h * TS + ts;
    const u16* Abase = VT + (size_t)(h * 256) * TP; const u16* Bbase = KT + (size_t)(h * 128) * TP;
    uint4 ar0, ar1, ar2, ar3, br0, br1;
    P1_GLOAD(0);
    float* swk = (float*)(smem + 110592);
    if (tid < 256) swk[tid] = wkp[tid];
    float nacc = 0.f;
    f32x4 acc[2][8];
#pragma unroll
    for (int i = 0; i < 2; ++i)
#pragma unroll
        for (int j = 0; j < 8; ++j) acc[i][j] = (f32x4){0.f, 0.f, 0.f, 0.f};
#pragma unroll 1
    for (int blk = 0; blk < RB; ++blk) {
        P1_LSTORE(blk & 1);
        __syncthreads();
        if (blk + 1 < RB) P1_GLOAD(blk + 1);
        const u16* As = (const u16*)(smem + (blk & 1) * 55296); const u16* Bs = As + 18432;
#pragma unroll
        for (int ks = 0; ks < 2; ++ks) {
            const float4 w0 = *(const float4*)(swk + 64 * blk + 32 * ks + 8 * q), w1 = *(const float4*)(swk + 64 * blk + 32 * ks + 8 * q + 4);
            bf16x8 af[2];
#pragma unroll
            for (int mt = 0; mt < 2; ++mt) af[mt] = scale_frag(*(const uint4*)(As + (32 * wave + 16 * mt + r) * 72 + 32 * ks + 8 * q), w0, w1);
#pragma unroll
            for (int nt = 0; nt < 8; ++nt) { const bf16x8 bfr = *(const bf16x8*)(Bs + (16 * nt + r) * 72 + 32 * ks + 8 * q);
#pragma unroll
                for (int mt = 0; mt < 2; ++mt) acc[mt][nt] = MFMA16(bfr, af[mt], acc[mt][nt]); }
        }
        if (tid < 128) {
#pragma unroll
            for (int c8 = 0; c8 < 8; ++c8) { const uint4 v = *(const uint4*)(Bs + tid * 72 + c8 * 8); float kf_[8]; unpack8(v, kf_);
                const float4 w0 = *(const float4*)(swk + 64 * blk + c8 * 8), w1 = *(const float4*)(swk + 64 * blk + c8 * 8 + 4);
                nacc += kf_[0] * w0.x + kf_[1] * w0.y + kf_[2] * w0.z + kf_[3] * w0.w + kf_[4] * w1.x + kf_[5] * w1.y + kf_[6] * w1.z + kf_[7] * w1.w; } }
    }
    u16* dst = (u16*)(a.ws + OFF_MCD) + ((size_t)(h * NSUP + sc) * 256) * 128;
#pragma unroll
    for (int mt = 0; mt < 2; ++mt)
#pragma unroll
        for (int nt = 0; nt < 8; ++nt)
        { uint2 o; o.x = pk2(acc[mt][nt][0], acc[mt][nt][1]); o.y = pk2(acc[mt][nt][2], acc[mt][nt][3]); *(uint2*)(dst + (size_t)(32 * wave + 16 * mt + r) * 128 + 16 * nt + 4 * q) = o; }
    if (tid < 128) misc[MI_MND + (h * NSUP + sc) * 128 + tid] = nacc;
    __syncthreads();
}
__device__ __forceinline__ void ssd_pass1(const Args& a, unsigned char* smem, int g, int sc, int hhalf) {
    const int tid = tid_opaque(), lane = tid & 63, wave = __builtin_amdgcn_readfirstlane(tid >> 6), r = lane & 15, q = lane >> 4;
    const u16* XT = (const u16*)(a.ws + OFF_XT); const u16* BT = (const u16*)(a.ws + OFF_BT);
    const int ts = sc * SUPT, hl = wave >> 1, nh = wave & 1, hh = g * 8 + hhalf * 4 + hl, srow = tid >> 3, spc = (tid & 7) * 8;
    const u16* Abase = XT + (size_t)((g * 8 + hhalf * 4) * 64) * TP; const u16* Bbase = BT + (size_t)(g * 128) * TP;
    const float* swh = (const float*)(a.ws + OFF_SCAL) + SC_SSW + hh * TS + ts + 8 * q;
    uint4 ar0, ar1, ar2, ar3, br0, br1;
    P1_GLOAD(0);
    float* ssw = (float*)(smem + 110592);
    { const int hl2 = tid >> 7, tk2 = (tid & 127) * 2;
      *(float2*)(ssw + hl2 * 256 + tk2) = *(const float2*)((const float*)(a.ws + OFF_SCAL) + SC_SSW + (size_t)(g * 8 + hhalf * 4 + hl2) * TS + ts + tk2); }
    f32x4 acc[4][4];
#pragma unroll
    for (int i = 0; i < 4; ++i)
#pragma unroll
        for (int j = 0; j < 4; ++j) acc[i][j] = (f32x4){0.f, 0.f, 0.f, 0.f};
#pragma unroll 1
    for (int blk = 0; blk < RB; ++blk) {
        P1_LSTORE(blk & 1);
        __syncthreads();
        if (blk + 1 < RB) P1_GLOAD(blk + 1);
        const u16* As = (const u16*)(smem + (blk & 1) * 55296); const u16* Bs = As + 18432;
#pragma unroll
        for (int ks = 0; ks < 2; ++ks) {
            const float4 w0 = *(const float4*)(ssw + hl * 256 + 64 * blk + 32 * ks + 8 * q), w1 = *(const float4*)(ssw + hl * 256 + 64 * blk + 32 * ks + 8 * q + 4);
            bf16x8 af[4];
#pragma unroll
            for (int mt = 0; mt < 4; ++mt) af[mt] = scale_frag(*(const uint4*)(As + (hl * 64 + 16 * mt + r) * 72 + 32 * ks + 8 * q), w0, w1);
#pragma unroll
            for (int nt = 0; nt < 4; ++nt) { const bf16x8 bfr = *(const bf16x8*)(Bs + (64 * nh + 16 * nt + r) * 72 + 32 * ks + 8 * q);
#pragma unroll
                for (int mt = 0; mt < 4; ++mt) acc[mt][nt] = MFMA16(bfr, af[mt], acc[mt][nt]); }
        }
    }
    u16* dst = (u16*)(a.ws + OFF_SSD) + ((size_t)(hh * NSUP + sc) * 64) * 128;
#pragma unroll
    for (int mt = 0; mt < 4; ++mt)
#pragma unroll
        for (int nt = 0; nt < 4; ++nt)
        { uint2 o; o.x = pk2(acc[mt][nt][0], acc[mt][nt][1]); o.y = pk2(acc[mt][nt][2], acc[mt][nt][3]); *(uint2*)(dst + (size_t)(16 * mt + r) * 128 + 64 * nh + 16 * nt + 4 * q) = o; }
    __syncthreads();
}
#undef P1_GLOAD
#undef P1_LSTORE

__device__ __forceinline__ void phase_scan(const Args& a, unsigned char* smem) {
    const int tid = tid_opaque();
    const int gt = blockIdx.x * 512 + tid, total = gridDim.x * 512;
    float* misc = (float*)(a.ws + OFF_MISC);
    float* tdec = (float*)smem; float* twl = tdec + NSUP; float* tdec2 = twl + NSUP; float* tat = tdec2 + NSUP; float* tml = tat + NSUP; float* tm = tml + NSUP;
    for (int p = gt; p < 131072; p += total) {
        const int h = p >> 14, rem = p & 16383, hh = p >> 12, rem2 = p & 4095;
        const unsigned* dl = (const unsigned*)((const u16*)(a.ws + OFF_MCD) + (size_t)h * NSUP * 32768) + rem;
        unsigned* ob = (unsigned*)((u16*)(a.ws + OFF_MCB) + (size_t)h * NSUP * 32768) + rem;
        const unsigned* dl2 = (const unsigned*)((const u16*)(a.ws + OFF_SSD) + (size_t)hh * NSUP * 8192) + rem2;
        unsigned* ob2 = (unsigned*)((u16*)(a.ws + OFF_SSB) + (size_t)hh * NSUP * 8192) + rem2;
        unsigned d[16], e[16];
#pragma unroll
        for (int u = 0; u < 16; ++u) { d[u] = dl[(size_t)u * 16384]; e[u] = dl2[(size_t)u * 4096]; }
        __syncthreads();
        if (tid < NSUP) { tat[tid] = misc[MI_MATOT + h * NSUP + tid]; tml[tid] = misc[MI_MMLOC + h * NSUP + tid]; tdec2[tid] = __expf(misc[MI_SATOT + hh * NSUP + tid]); }
        __syncthreads();
        if (tid == 0) { float m = 0.f;
            for (int sc = 0; sc < NSUP; ++sc) { const float at = tat[sc], ml = tml[sc]; tm[sc] = m;
                const float mn = fmaxf(at + m, ml); tdec[sc] = __expf(at + m - mn); twl[sc] = __expf(ml - mn); m = mn; } }
        __syncthreads();
        if (((p - tid) & 16383) == 0 && tid < NSUP) misc[MI_MMST + h * NSUP + tid] = tm[tid];
        float2 C = {0.f, 0.f}, nv = {0.f, 0.f}, S = {0.f, 0.f};
        const bool do_n = rem < 64;
        for (int s0 = 0; s0 < NSUP; s0 += 16) {
            if (s0 > 0) {
#pragma unroll
                for (int u = 0; u < 16; ++u) { d[u] = dl[(size_t)(s0 + u) * 16384]; e[u] = dl2[(size_t)(s0 + u) * 4096]; } }
#pragma unroll
            for (int u = 0; u < 16; ++u) { const int sc = s0 + u;
                ob[(size_t)sc * 16384] = pk2(C.x, C.y);
                ob2[(size_t)sc * 4096] = pk2(S.x, S.y);
                const float dec = tdec[sc], wl = twl[sc], dec2 = tdec2[sc];
                if (do_n) { ((float2*)(misc + MI_MNS + (h * NSUP + sc) * 128))[rem] = nv;
                    const float2 dn = ((const float2*)(misc + MI_MND + (h * NSUP + sc) * 128))[rem]; nv.x = dec * nv.x + wl * dn.x; nv.y = dec * nv.y + wl * dn.y; }
                C.x = dec * C.x + wl * __uint_as_float(d[u] << 16); C.y = dec * C.y + wl * __uint_as_float(d[u] & 0xffff0000u);
                S.x = dec2 * S.x + __uint_as_float(e[u] << 16); S.y = dec2 * S.y + __uint_as_float(e[u] & 0xffff0000u); }
        }
    }
}

__device__ __forceinline__ void ml_pass2(const Args& a, unsigned char* smem, int h, int c) {
    const int tid = tid_opaque(), lane = tid & 63, wave = __builtin_amdgcn_readfirstlane(tid >> 6), r = lane & 15, q = lane >> 4;
    u16* Qs = (u16*)smem; u16* Ps = (u16*)(smem + 125952);
    float* sbk = (float*)(smem + 144384); float* spm = sbk + 256; float* sam = spm + 64; float* srd = sam + 64; float* sqn = srd + 64;
    float* Ht = (float*)(smem + 17408);
    const u16* QC = (const u16*)(a.ws + OFF_QC); const u16* KC = (const u16*)(a.ws + OFF_KC); const u16* VT = (const u16*)(a.ws + OFF_VT);
    const u16* O = (const u16*)(a.ws + OFF_O); const u16* ZM = (const u16*)(a.ws + OFF_ZM);
    const float* misc = (const float*)(a.ws + OFF_MISC);
    const int sc = c / RB, j = c % RB, t0 = c * 64, ts = sc * SUPT;
    uint4 kr0, kr1, vr0, vr1, vr2, vr3;
    const int kidx_t = tid >> 4, kidx_p = (tid & 15) * 8, vidx_d = tid >> 3, vidx_p = (tid & 7) * 8;
#define ML2_GLOAD(blk) do { const int tk0_ = ts + 64 * (blk); \
        kr0 = *(const uint4*)(KC + (size_t)(tk0_ + kidx_t) * 1024 + h * 128 + kidx_p); kr1 = *(const uint4*)(KC + (size_t)(tk0_ + 32 + kidx_t) * 1024 + h * 128 + kidx_p); \
        vr0 = *(const uint4*)(VT + (size_t)(h * 256 + vidx_d) * TP + tk0_ + vidx_p); vr1 = *(const uint4*)(VT + (size_t)(h * 256 + 64 + vidx_d) * TP + tk0_ + vidx_p); \
        vr2 = *(const uint4*)(VT + (size_t)(h * 256 + 128 + vidx_d) * TP + tk0_ + vidx_p); vr3 = *(const uint4*)(VT + (size_t)(h * 256 + 192 + vidx_d) * TP + tk0_ + vidx_p); } while (0)
#define ML2_LSTORE(stage) do { u16* Ks_ = (u16*)(smem + 17408 + (stage) * 54272); u16* Vs_ = Ks_ + 8704; \
        *(uint4*)(Ks_ + kidx_t * 136 + kidx_p) = kr0; *(uint4*)(Ks_ + (32 + kidx_t) * 136 + kidx_p) = kr1; \
        *(uint4*)(Vs_ + vidx_d * 72 + vidx_p) = vr0; *(uint4*)(Vs_ + (64 + vidx_d) * 72 + vidx_p) = vr1; *(uint4*)(Vs_ + (128 + vidx_d) * 72 + vidx_p) = vr2; *(uint4*)(Vs_ + (192 + vidx_d) * 72 + vidx_p) = vr3; } while (0)
    ML2_GLOAD(0);
    bf16x8 cfr[2][4];
    { const u16* CT = (const u16*)(a.ws + OFF_MCB) + ((size_t)(h * NSUP + sc) * 256) * 128 + (size_t)(32 * wave + r) * 128 + 8 * q;
#pragma unroll
      for (int n2 = 0; n2 < 2; ++n2)
#pragma unroll
          for (int ks = 0; ks < 4; ++ks) cfr[n2][ks] = LDFRAG(CT + (size_t)(16 * n2) * 128 + 32 * ks); }
    const float mst = misc[MI_MMST + h * NSUP + sc];
    { const float* scal = (const float*)(a.ws + OFF_SCAL);
      if (tid < 64 * (j + 1)) sbk[tid] = scal[SC_MLB + h * TS + ts + tid];
      if (tid >= 256 && tid < 320) { const int l = tid - 256; const float pmx = fmaxf(scal[SC_MLP + h * TS + t0 + l], mst); spm[l] = pmx; sam[l] = scal[SC_MLA + h * TS + t0 + l] + pmx; } }
    const uint4 qr0 = *(const uint4*)(QC + (size_t)(t0 + kidx_t) * 1024 + h * 128 + kidx_p), qr1 = *(const uint4*)(QC + (size_t)(t0 + 32 + kidx_t) * 1024 + h * 128 + kidx_p);
    {
      const float* nv = misc + MI_MNS + (h * NSUP + sc) * 128 + 16 * (tid & 7); const u16* qr = QC + (size_t)(t0 + (tid >> 3)) * 1024 + h * 128 + 16 * (tid & 7);
      const uint4 v0 = *(const uint4*)qr, v1 = *(const uint4*)(qr + 8); float f0[8], f1[8]; unpack8(v0, f0); unpack8(v1, f1);
      const float4 n0 = *(const float4*)nv, n1 = *(const float4*)(nv + 4), n2 = *(const float4*)(nv + 8), n3 = *(const float4*)(nv + 12);
      float sq = f0[0] * n0.x + f0[1] * n0.y + f0[2] * n0.z + f0[3] * n0.w + f0[4] * n1.x + f0[5] * n1.y + f0[6] * n1.z + f0[7] * n1.w
               + f1[0] * n2.x + f1[1] * n2.y + f1[2] * n2.z + f1[3] * n2.w + f1[4] * n3.x + f1[5] * n3.y + f1[6] * n3.z + f1[7] * n3.w;
      sq += __shfl_xor(sq, 1); sq += __shfl_xor(sq, 2); sq += __shfl_xor(sq, 4);
      if ((tid & 7) == 0) sqn[tid >> 3] = sq; }
    *(uint4*)(Qs + kidx_t * 136 + kidx_p) = qr0; *(uint4*)(Qs + (32 + kidx_t) * 136 + kidx_p) = qr1;
    ML2_LSTORE(0);
    __syncthreads();
    f32x4 acc[4][2];
#pragma unroll
    for (int i = 0; i < 4; ++i)
#pragma unroll
        for (int k = 0; k < 2; ++k) acc[i][k] = (f32x4){0.f, 0.f, 0.f, 0.f};
    {
#pragma unroll
      for (int ks = 0; ks < 4; ++ks) {
          bf16x8 af[4];
#pragma unroll
          for (int mt = 0; mt < 4; ++mt) af[mt] = *(const bf16x8*)(Qs + (16 * mt + r) * 136 + 32 * ks + 8 * q);
#pragma unroll
          for (int mt = 0; mt < 4; ++mt) { acc[mt][0] = MFMA16(af[mt], cfr[0][ks], acc[mt][0]); acc[mt][1] = MFMA16(af[mt], cfr[1][ks], acc[mt][1]); }
      }
#pragma unroll
      for (int mt = 0; mt < 4; ++mt)
#pragma unroll
          for (int jj = 0; jj < 4; ++jj) { const float wi = __expf(mst - spm[16 * mt + 4 * q + jj]); acc[mt][0][jj] *= wi; acc[mt][1][jj] *= wi; } }
    const int mtS = wave >> 1;
    bf16x8 qf[4];
#pragma unroll
    for (int ks = 0; ks < 4; ++ks) qf[ks] = *(const bf16x8*)(Qs + (16 * mtS + r) * 136 + 32 * ks + 8 * q);
    float den = 0.f;
#pragma unroll 1
    for (int i = 0; i <= j; ++i) {
        const u16* Ks = (const u16*)(smem + 17408 + (i & 1) * 54272); const u16* VTs = Ks + 8704;
        if (i < j) ML2_GLOAD(i + 1);
        u16* P = Ps + (i & 1) * 4608;
        { f32x4 s2[2] = {(f32x4){0.f, 0.f, 0.f, 0.f}, (f32x4){0.f, 0.f, 0.f, 0.f}};
#pragma unroll
          for (int ks = 0; ks < 4; ++ks)
#pragma unroll
              for (int u = 0; u < 2; ++u) s2[u] = MFMA16(qf[ks], *(const bf16x8*)(Ks + (16 * ((wave & 1) * 2 + u) + r) * 136 + 32 * ks + 8 * q), s2[u]);
#pragma unroll
          for (int u = 0; u < 2; ++u) { const int s = 16 * ((wave & 1) * 2 + u) + r; const float bs = sbk[i * 64 + s];
#pragma unroll
              for (int jj = 0; jj < 4; ++jj) { const int l = 16 * mtS + 4 * q + jj;
                  const float w = __expf(fminf(bs - spm[l], 0.f)); const bool ok = (i < j) || (s <= l);
                  P[l * 72 + s] = f2bf(ok ? s2[u][jj] * w : 0.f); } } }
        __syncthreads();
        if (i < j) ML2_LSTORE((i + 1) & 1);
#pragma unroll
        for (int ks = 0; ks < 2; ++ks) {
            bf16x8 af[4];
#pragma unroll
            for (int mt = 0; mt < 4; ++mt) af[mt] = *(const bf16x8*)(P + (16 * mt + r) * 72 + 32 * ks + 8 * q);
#pragma unroll
            for (int n2 = 0; n2 < 2; ++n2) { const bf16x8 bfr = *(const bf16x8*)(VTs + (32 * wave + 16 * n2 + r) * 72 + 32 * ks + 8 * q);
#pragma unroll
                for (int mt = 0; mt < 4; ++mt) acc[mt][n2] = MFMA16(af[mt], bfr, acc[mt][n2]); }
        }
        if (tid < 64) { float s = 0.f;
#pragma unroll
            for (int c8 = 0; c8 < 8; ++c8) { const uint4 v = *(const uint4*)(P + tid * 72 + c8 * 8); float ff[8]; unpack8(v, ff);
#pragma unroll
                for (int e = 0; e < 8; ++e) s += ff[e]; }
            den += s; }
        __syncthreads();
    }
#undef ML2_GLOAD
#undef ML2_LSTORE
    const int ecol = h * 256 + 8 * (tid & 7);
    uint4 eo[4];
#pragma unroll
    for (int k = 0; k < 4; ++k) { const size_t idx = (size_t)(t0 + (tid >> 3)) * 2048 + ecol + 64 * k; eo[k] = *(const uint4*)(O + idx); }
    if (tid < 64) { den += __expf(mst - spm[tid]) * sqn[tid]; srd[tid] = 1.f / fmaxf(fabsf(den), __expf(-sam[tid])); }
    __syncthreads();
#pragma unroll
    for (int mt = 0; mt < 4; ++mt)
#pragma unroll
        for (int jj = 0; jj < 4; ++jj) { const int l = 16 * mt + 4 * q + jj; const float rd = srd[l];
            Ht[l * 260 + 32 * wave + r] = acc[mt][0][jj] * rd; Ht[l * 260 + 32 * wave + 16 + r] = acc[mt][1][jj] * rd; }
    __syncthreads();
    { const int l = tid >> 3, jx = tid & 7; float v[4][8]; float ss = 0.f;
#pragma unroll
      for (int k = 0; k < 4; ++k) { const float* hp = Ht + l * 260 + 8 * (jx + 8 * k); const float4 a0 = *(const float4*)hp, a1 = *(const float4*)(hp + 4);
          v[k][0] = a0.x; v[k][1] = a0.y; v[k][2] = a0.z; v[k][3] = a0.w; v[k][4] = a1.x; v[k][5] = a1.y; v[k][6] = a1.z; v[k][7] = a1.w;
#pragma unroll
          for (int e = 0; e < 8; ++e) ss += v[k][e] * v[k][e]; }
      ss += __shfl_xor(ss, 1); ss += __shfl_xor(ss, 2); ss += __shfl_xor(ss, 4);
      const float rstd = rsqrtf(ss * (1.f / 256.f) + EPSN);
      const float* nw = a.in[9];
#pragma unroll
      for (int k = 0; k < 4; ++k) { const int col = h * 256 + 8 * (jx + 8 * k); const size_t idx = (size_t)(t0 + l) * 2048 + col;
          float of[8]; unpack8(eo[k], of);
          const float4 n0 = *(const float4*)(nw + col), n1 = *(const float4*)(nw + col + 4);
          const float nwv[8] = {n0.x, n0.y, n0.z, n0.w, n1.x, n1.y, n1.z, n1.w};
          float y[8];
#pragma unroll
          for (int e = 0; e < 8; ++e) y[e] = of[e] * (v[k][e] * rstd * nwv[e]);
          *(uint4*)((u16*)(a.ws + OFF_YM) + idx) = pack8(y); } }
    __syncthreads();
}
__device__ __forceinline__ void ssd_pass2(const Args& a, unsigned char* smem, int g, int c) {
    const int tid = tid_opaque(), lane = tid & 63, wave = __builtin_amdgcn_readfirstlane(tid >> 6), r = lane & 15, q = lane >> 4;
    float* sS = (float*)smem; float* sa = (float*)(smem + 17408); float* sdt = (float*)(smem + 25600); float* Yt = (float*)smem;
    u16* Cs = (u16*)(smem + 33792); u16* Bs = (u16*)(smem + 51200); u16* XTs = (u16*)(smem + 68608);
    const u16* CC = (const u16*)(a.ws + OFF_CC); const u16* BC = (const u16*)(a.ws + OFF_BC); const u16* XT = (const u16*)(a.ws + OFF_XT);
    const u16* ZS = (const u16*)(a.ws + OFF_ZS);
    const int sc = c / RB, j = c % RB, t0 = c * 64, ts = sc * SUPT, hh = g * 8 + wave;
    const int bt = tid >> 4, bp = (tid & 15) * 8, xr = tid >> 3, xp = (tid & 7) * 8;
    uint4 b0, b1, x0, x1, x2, x3, x4, x5, x6, x7;
#define SS2_GLOAD(blk) do { const int tk0_ = ts + 64 * (blk); \
        b0 = *(const uint4*)(BC + (size_t)(tk0_ + bt) * 512 + g * 128 + bp); b1 = *(const uint4*)(BC + (size_t)(tk0_ + 32 + bt) * 512 + g * 128 + bp); \
        const u16* xb_ = XT + (size_t)(g * 512 + xr) * TP + tk0_ + xp; \
        x0 = *(const uint4*)(xb_); x1 = *(const uint4*)(xb_ + (size_t)64 * TP); x2 = *(const uint4*)(xb_ + (size_t)128 * TP); x3 = *(const uint4*)(xb_ + (size_t)192 * TP); \
        x4 = *(const uint4*)(xb_ + (size_t)256 * TP); x5 = *(const uint4*)(xb_ + (size_t)320 * TP); x6 = *(const uint4*)(xb_ + (size_t)384 * TP); x7 = *(const uint4*)(xb_ + (size_t)448 * TP); } while (0)
#define SS2_LSTORE() do { *(uint4*)(Bs + bt * 136 + bp) = b0; *(uint4*)(Bs + (32 + bt) * 136 + bp) = b1; u16* xd_ = XTs + xr * 72 + xp; \
        *(uint4*)(xd_) = x0; *(uint4*)(xd_ + 64 * 72) = x1; *(uint4*)(xd_ + 128 * 72) = x2; *(uint4*)(xd_ + 192 * 72) = x3; \
        *(uint4*)(xd_ + 256 * 72) = x4; *(uint4*)(xd_ + 320 * 72) = x5; *(uint4*)(xd_ + 384 * 72) = x6; *(uint4*)(xd_ + 448 * 72) = x7; } while (0)
    SS2_GLOAD(0);
    bf16x8 sfr[4][4];
    { const u16* Sg = (const u16*)(a.ws + OFF_SSB) + ((size_t)(hh * NSUP + sc) * 64) * 128 + (size_t)r * 128 + 8 * q;
#pragma unroll
      for (int nt = 0; nt < 4; ++nt)
#pragma unroll
          for (int ks = 0; ks < 4; ++ks) sfr[nt][ks] = LDFRAG(Sg + (size_t)(16 * nt) * 128 + 32 * ks); }
    { const uint4 c0 = *(const uint4*)(CC + (size_t)(t0 + bt) * 512 + g * 128 + bp), c1 = *(const uint4*)(CC + (size_t)(t0 + 32 + bt) * 512 + g * 128 + bp);
      *(uint4*)(Cs + bt * 136 + bp) = c0; *(uint4*)(Cs + (32 + bt) * 136 + bp) = c1; }
    { const float* scal = (const float*)(a.ws + OFF_SCAL);
      for (int blk = 0; blk <= j; ++blk) { const int t = ts + blk * 64 + lane;
          sa[wave * 256 + blk * 64 + lane] = scal[SC_SSA + hh * TS + t]; sdt[wave * 256 + blk * 64 + lane] = scal[SC_SSD + hh * TS + t]; } }
    __syncthreads();
    f32x4 acc[4][4];
#pragma unroll
    for (int i = 0; i < 4; ++i)
#pragma unroll
        for (int k = 0; k < 4; ++k) acc[i][k] = (f32x4){0.f, 0.f, 0.f, 0.f};
    {
#pragma unroll
      for (int ks = 0; ks < 4; ++ks) {
          bf16x8 af[4];
#pragma unroll
          for (int mt = 0; mt < 4; ++mt) af[mt] = *(const bf16x8*)(Cs + (16 * mt + r) * 136 + 32 * ks + 8 * q);
#pragma unroll
          for (int nt = 0; nt < 4; ++nt)
#pragma unroll
              for (int mt = 0; mt < 4; ++mt) acc[mt][nt] = MFMA16(af[mt], sfr[nt][ks], acc[mt][nt]);
      }
#pragma unroll
      for (int mt = 0; mt < 4; ++mt)
#pragma unroll
          for (int jj = 0; jj < 4; ++jj) { const float ea = __expf(sa[wave * 256 + j * 64 + 16 * mt + 4 * q + jj]);
#pragma unroll
              for (int nt = 0; nt < 4; ++nt) acc[mt][nt][jj] *= ea; } }
    const int mtS = wave >> 1;
#pragma unroll 1
    for (int i = 0; i <= j; ++i) {
        SS2_LSTORE();
        __syncthreads();
        if (i < j) SS2_GLOAD(i + 1);
        { f32x4 s2[2] = {(f32x4){0.f, 0.f, 0.f, 0.f}, (f32x4){0.f, 0.f, 0.f, 0.f}};
#pragma unroll
          for (int ks = 0; ks < 4; ++ks) { const bf16x8 cfr = *(const bf16x8*)(Cs + (16 * mtS + r) * 136 + 32 * ks + 8 * q);
#pragma unroll
              for (int u = 0; u < 2; ++u) s2[u] = MFMA16(cfr, *(const bf16x8*)(Bs + (16 * ((wave & 1) * 2 + u) + r) * 136 + 32 * ks + 8 * q), s2[u]); }
#pragma unroll
          for (int u = 0; u < 2; ++u)
#pragma unroll
              for (int jj = 0; jj < 4; ++jj) sS[(16 * mtS + 4 * q + jj) * 68 + 16 * ((wave & 1) * 2 + u) + r] = s2[u][jj]; }
        __syncthreads();
#pragma unroll
        for (int ks = 0; ks < 2; ++ks) {
            bf16x8 af[4];
            const int sb0 = 32 * ks + 8 * q;
            const float4 as0 = *(const float4*)(sa + wave * 256 + i * 64 + sb0), as1 = *(const float4*)(sa + wave * 256 + i * 64 + sb0 + 4);
            const float4 ds0 = *(const float4*)(sdt + wave * 256 + i * 64 + sb0), ds1 = *(const float4*)(sdt + wave * 256 + i * 64 + sb0 + 4);
            const float asv[8] = {as0.x, as0.y, as0.z, as0.w, as1.x, as1.y, as1.z, as1.w};
            const float dsv[8] = {ds0.x, ds0.y, ds0.z, ds0.w, ds1.x, ds1.y, ds1.z, ds1.w};
#pragma unroll
            for (int mt = 0; mt < 4; ++mt) { const int l = 16 * mt + r; const float al = sa[wave * 256 + j * 64 + l];
                const float4 v0 = *(const float4*)(sS + l * 68 + sb0), v1 = *(const float4*)(sS + l * 68 + sb0 + 4);
                const float sv[8] = {v0.x, v0.y, v0.z, v0.w, v1.x, v1.y, v1.z, v1.w};
                float mv[8];
#pragma unroll
                for (int e = 0; e < 8; ++e) { const bool ok = (i < j) || (sb0 + e <= l);
                    mv[e] = ok ? sv[e] * __expf(fminf(al - asv[e], 0.f)) * dsv[e] : 0.f; }
                const uint4 pk = pack8(mv);
                af[mt] = __builtin_bit_cast(bf16x8, pk); }
#pragma unroll
            for (int nt = 0; nt < 4; ++nt) { const bf16x8 xfr = *(const bf16x8*)(XTs + (wave * 64 + 16 * nt + r) * 72 + 32 * ks + 8 * q);
#pragma unroll
                for (int mt = 0; mt < 4; ++mt) acc[mt][nt] = MFMA16(af[mt], xfr, acc[mt][nt]); }
        }
        if (i < j) __syncthreads();
    }
#undef SS2_GLOAD
#undef SS2_LSTORE
    uint4 ezs[8];
#pragma unroll
    for (int k = 0; k < 8; ++k) ezs[k] = *(const uint4*)(ZS + (size_t)(t0 + (tid >> 3)) * 2048 + g * 512 + 8 * ((tid & 7) + 8 * k));
    { const float Dh = a.in[13][hh];
#pragma unroll
      for (int mt = 0; mt < 4; ++mt)
#pragma unroll
          for (int nt = 0; nt < 4; ++nt) { const uint2 xv = *(const uint2*)(XTs + (wave * 64 + 16 * nt + r) * 72 + 16 * mt + 4 * q);
              acc[mt][nt][0] += Dh * __uint_as_float(xv.x << 16); acc[mt][nt][1] += Dh * __uint_as_float(xv.x & 0xffff0000u);
              acc[mt][nt][2] += Dh * __uint_as_float(xv.y << 16); acc[mt][nt][3] += Dh * __uint_as_float(xv.y & 0xffff0000u); } }
    __syncthreads();
#pragma unroll
    for (int mt = 0; mt < 4; ++mt)
#pragma unroll
        for (int nt = 0; nt < 4; ++nt)
#pragma unroll
            for (int jj = 0; jj < 4; ++jj) Yt[(16 * mt + 4 * q + jj) * 516 + wave * 64 + 16 * nt + r] = acc[mt][nt][jj];
    __syncthreads();
    { const int l = tid >> 3, jx = tid & 7; float v[8][8]; float ss = 0.f;
      const u16* zrow = ZS + (size_t)(t0 + l) * 2048 + g * 512;
#pragma unroll
      for (int k = 0; k < 8; ++k) { const int pc = jx + 8 * k; const float* yp = Yt + l * 516 + 8 * pc; const float4 a0 = *(const float4*)yp, a1 = *(const float4*)(yp + 4);
          float zf[8]; unpack8(ezs[k], zf);
          v[k][0] = a0.x * zf[0]; v[k][1] = a0.y * zf[1]; v[k][2] = a0.z * zf[2]; v[k][3] = a0.w * zf[3];
          v[k][4] = a1.x * zf[4]; v[k][5] = a1.y * zf[5]; v[k][6] = a1.z * zf[6]; v[k][7] = a1.w * zf[7];
#pragma unroll
          for (int e = 0; e < 8; ++e) ss += v[k][e] * v[k][e]; }
      ss += __shfl_xor(ss, 1); ss += __shfl_xor(ss, 2); ss += __shfl_xor(ss, 4);
      const float rstd = rsqrtf(ss * (1.f / 512.f) + EPSN);
      const float* nw = a.in[14] + g * 512;
#pragma unroll
      for (int k = 0; k < 8; ++k) { const int pc = jx + 8 * k;
          const float4 n0 = *(const float4*)(nw + 8 * pc), n1 = *(const float4*)(nw + 8 * pc + 4);
          float y[8] = {v[k][0] * rstd * n0.x, v[k][1] * rstd * n0.y, v[k][2] * rstd * n0.z, v[k][3] * rstd * n0.w,
                        v[k][4] * rstd * n1.x, v[k][5] * rstd * n1.y, v[k][6] * rstd * n1.z, v[k][7] * rstd * n1.w};
          *(uint4*)((u16*)(a.ws + OFF_YS) + (size_t)(t0 + l) * 2048 + g * 512 + 8 * pc) = pack8(y); } }
    __syncthreads();
}

__device__ __forceinline__ void phase_final(const Args& a, int b) {
    const int tid = tid_opaque(), lane = tid & 63, wave = __builtin_amdgcn_readfirstlane(tid >> 6);
    const float* x = a.in[0]; const float* fw = a.in[18]; const float* gate = (const float*)(a.ws + OFF_MISC) + MI_MOD + b * 3072 + 2048;
    const u16* P1 = (const u16*)(a.ws + OFF_P1);
    for (int ml = blockIdx.x * 8 + wave; ml < TS; ml += gridDim.x * 8) {
        const size_t m = (size_t)b * TS + ml;
        const float4* xr = (const float4*)(x + m * DM) + lane; float4* orow = (float4*)(a.out + m * DM) + lane;
        const uint2* p0r = (const uint2*)(a.out + m * DM) + lane; const uint2* p1r = (const uint2*)(P1 + (size_t)ml * DM) + lane;
        float4 v[4]; float ss = 0.f;
#pragma unroll
        for (int j = 0; j < 4; ++j) { const float4 xv = xr[64 * j]; const uint2 q0 = p0r[64 * j], q1 = p1r[64 * j]; const float4 gt = *(const float4*)(gate + 4 * lane + 256 * j);
            const float s0 = __uint_as_float(q0.x << 16) + __uint_as_float(q1.x << 16), s1 = __uint_as_float(q0.x & 0xffff0000u) + __uint_as_float(q1.x & 0xffff0000u);
            const float s2 = __uint_as_float(q0.y << 16) + __uint_as_float(q1.y << 16), s3 = __uint_as_float(q0.y & 0xffff0000u) + __uint_as_float(q1.y & 0xffff0000u);
            v[j].x = xv.x + gt.x * s0; v[j].y = xv.y + gt.y * s1; v[j].z = xv.z + gt.z * s2; v[j].w = xv.w + gt.w * s3;
            ss += v[j].x * v[j].x + v[j].y * v[j].y + v[j].z * v[j].z + v[j].w * v[j].w; }
        const float rstd = rsqrtf(wave_sum(ss) * (1.f / DM) + EPSN);
#pragma unroll
        for (int j = 0; j < 4; ++j) { const float4 w = *(const float4*)(fw + 4 * lane + 256 * j);
            float4 o; o.x = v[j].x * rstd * w.x; o.y = v[j].y * rstd * w.y; o.z = v[j].z * rstd * w.z; o.w = v[j].w * rstd * w.w; orow[64 * j] = o; }
    }
}

#define XB_TMO      128
#define XB_XCNT(j)  (256  + 64 * (j))
#define XB_XSUB(j)  (1280 + 64 * (j))
#define XB_XGEN(j)  (2304 + 64 * (j))
#define XB_TOP      3328
#define XB_TOPGEN   3392
#define XCD_BAR_WORDS 3456
#define XB_SPIN_CAP (1u << 18)
#define LAS __attribute__((address_space(3)))

__device__ __forceinline__ unsigned xb_ld(unsigned* p)              { return __hip_atomic_load(p, __ATOMIC_RELAXED, __HIP_MEMORY_SCOPE_AGENT); }
__device__ __forceinline__ unsigned xb_add(unsigned* p, unsigned v) { return __hip_atomic_fetch_add(p, v, __ATOMIC_RELAXED, __HIP_MEMORY_SCOPE_AGENT); }
__device__ __forceinline__ unsigned xb_xcc_id() { return (unsigned)__builtin_amdgcn_s_getreg((3 << 11) | 20) & 0xFu; }
#define XB_SPIN(cond, bar) do { unsigned _sp = 0; while (cond) { __builtin_amdgcn_s_sleep(1); \
    if ((++_sp & 255u) == 0u) { if (xb_ld(&(bar)[XB_TMO])) break; if (_sp > XB_SPIN_CAP) { atomicAdd(&(bar)[XB_TMO], 1u); break; } } } } while (0)

struct XcdBarrier {
    unsigned* bar; unsigned x;
    volatile LAS unsigned* st;
};

__device__ __forceinline__ XcdBarrier xcd_barrier_post(unsigned* bar, volatile LAS unsigned* st) {
    XcdBarrier b; b.bar = bar; b.x = xb_xcc_id(); b.st = st;
    if (threadIdx.x == 0) (void)xb_add(&bar[XB_XCNT(b.x)], 1u);
    return b;
}
__device__ __forceinline__ void xcd_barrier_complete(unsigned* bar, unsigned x, unsigned& nloc, unsigned& nx) {
    const unsigned G = gridDim.x * gridDim.y * gridDim.z;
    unsigned sum, cnt, mine, sp = 0u;
    for (;;) {
        sum = 0u; cnt = 0u; mine = 0u;
#pragma unroll
        for (unsigned j = 0; j < 16; ++j) { const unsigned c = xb_ld(&bar[XB_XCNT(j)]); sum += c; cnt += (c > 0u) ? 1u : 0u; mine = (j == x) ? c : mine; }
        if (sum == G) break;
        __builtin_amdgcn_s_sleep(1);
        if ((++sp & 255u) == 0u) { if (xb_ld(&bar[XB_TMO])) break; if (sp > XB_SPIN_CAP) { atomicAdd(&bar[XB_TMO], 1u); break; } }
    }
    nloc = mine > 0u ? mine : 1u; nx = cnt > 0u ? cnt : 1u;
}

__device__ __forceinline__ void xcd_barrier(const XcdBarrier& b) {
    asm volatile("s_waitcnt vmcnt(0)" ::: "memory");
    __syncthreads();
    if (threadIdx.x == 0) {
        unsigned* bar = b.bar;
        __builtin_amdgcn_s_waitcnt(0);
        unsigned nloc = b.st[0], nx = b.st[1];
        if (nloc == 0u) { xcd_barrier_complete(bar, b.x, nloc, nx); b.st[0] = nloc; b.st[1] = nx; }
        const unsigned old = xb_add(&bar[XB_XSUB(b.x)], 1u);
        const unsigned gen = old / nloc;
        if (old + 1u == (gen + 1u) * nloc) {
            __builtin_amdgcn_fence(__ATOMIC_RELEASE, "agent");
            asm volatile("s_waitcnt vmcnt(0)" ::: "memory");
            const unsigned og = xb_add(&bar[XB_TOP], 1u);
            const unsigned tg = og / nx;
            if (og + 1u == (tg + 1u) * nx) xb_add(&bar[XB_TOPGEN], 1u);
            else XB_SPIN(xb_ld(&bar[XB_TOPGEN]) == tg, bar);
            __builtin_amdgcn_fence(__ATOMIC_ACQUIRE, "agent");
            xb_add(&bar[XB_XGEN(b.x)], 1u);
            asm volatile("s_waitcnt vmcnt(0)" ::: "memory");
        } else {
            XB_SPIN(xb_ld(&bar[XB_XGEN(b.x)]) == gen, bar);
            __builtin_amdgcn_fence(__ATOMIC_ACQUIRE, "agent");
            asm volatile("s_waitcnt vmcnt(0)" ::: "memory");
        }
    }
    __syncthreads();
}


constexpr int N_PHASES = 2 + 4 * 8;
__global__ void __launch_bounds__(512, 2) fwd(Args a) {
    extern __shared__ __attribute__((aligned(16))) unsigned char smem[];
    cg::grid_group grid = cg::this_grid();
    const int bid = blockIdx.x, G = gridDim.x;
    PG8_LAS unsigned char* lds = (PG8_LAS unsigned char*)smem;
    __shared__ uint4 xb_words;
    if (threadIdx.x == 0) xb_words = make_uint4(0u, 0u, 0u, 0u);
    __syncthreads();
    XcdBarrier xbar = xcd_barrier_post((unsigned*)(a.ws + OFF_BAR), (volatile LAS unsigned*)&xb_words);
    for (int ph = a.ph_lo; ph < a.ph_hi; ++ph) {
        bool need_sync = true;
        if (ph == 0) phase0(a, smem);
        else if (ph == 1) phase1(a);
        else {
            const int b = (ph - 2) / 8, k0_ = (ph - 2) % 8, k = (k0_ == 0) ? 0 : k0_ - 1;
#ifdef REP_K
            for (int rep_ = 0; rep_ < ((k0_ == REP_K) ? 2 : 1); ++rep_) { if (rep_) xcd_barrier(xbar);
#endif
            if (k0_ == 1) phase_conv(a); else
            if (k == 0) {
                pg8::Gemm g{(const pg8::bf16_t*)((unsigned char*)a.out + U_OFF_IN_OUT) + (size_t)b * TS * DM, (const pg8::bf16_t*)(a.ws + OFF_WIN), TS, NPAD, DM};
                pg8::StaticOrder S; S.init(TS, NPAD, G, bid);
                EpiProj E{a.ws, (const float*)(a.ws + OFF_MISC) + MI_BIAS};
                pg8::gemm_phase<EpiProj, pg8::StaticOrder, true, true>(lds, g, S, E);
            } else if (k == 1) {
                for (int it = bid; it < 512; it += G) {
                    if (it < 256) ml_pass1(a, smem, it & 7, it >> 3);
                    else { const int x = it - 256; ssd_pass1(a, smem, x & 3, x >> 3, (x >> 2) & 1); }
                }
            } else if (k == 2) phase_scan(a, smem);
            else if (k == 3) {
                for (int it = bid; it < 1536; it += G) {
#if defined(REP_K) && defined(REP_SUB)
                    if (rep_ && ((it < 1024) != (REP_SUB == 1))) continue;
#endif
                    if (it < 1024) { const int h = it & 7, cc = it >> 3, kk = (it >> 8) & 3; ml_pass2(a, smem, h, cc ^ kk); }
                    else { const int x = it - 1024, g = x & 3, cc = x >> 2, kk = (x >> 8) & 1; ssd_pass2(a, smem, g, cc ^ (kk * 3)); }
                }
            } else if (k == 4) {
                const int half = G >> 1, sel = (bid >= half) ? 1 : 0, c = bid - sel * half;
                if (c < half) {
                    pg8::Gemm g{(const pg8::bf16_t*)(a.ws + (sel ? OFF_YS : OFF_YM)), (const pg8::bf16_t*)(a.ws + (sel ? OFF_WS : OFF_WM)), TS, DM, 2048};
                    pg8::StaticOrder S; S.init(TS, DM, half, c);
                    EpiMerge E{(const u16*)(a.ws + OFF_MG), (u16*)(a.ws + (sel ? OFF_G1 : OFF_G0)), sel};
                    pg8::gemm_phase<EpiMerge, pg8::StaticOrder, true, true>(lds, g, S, E);
                }
            } else if (k == 5) {
                const int half = G >> 1, sel = (bid >= half) ? 1 : 0, c = bid - sel * half;
                if (c < half) {
                    pg8::Gemm g{(const pg8::bf16_t*)(a.ws + (sel ? OFF_G1 : OFF_G0)), (const pg8::bf16_t*)(a.ws + OFF_WO), TS, DM, DM};
                    pg8::StaticOrder S; S.init(TS, DM, half, c);
                    EpiOut E{sel ? (u16*)(a.ws + OFF_P1) : (u16*)(a.out + (size_t)b * TS * DM), sel ? 1024 : 2048};
                    pg8::gemm_phase<EpiOut, pg8::StaticOrder, true, true>(lds, g, S, E);
                }
            } else { phase_final(a, b); need_sync = false; }
#ifdef REP_K
            }
#endif
        }
        if (need_sync && ph + 1 < a.ph_hi) {
            if (a.ph_lo < 0) grid.sync();
            else xcd_barrier(xbar);
        }
    }
}

extern "C" void kernel_launch(void* const* d_in, const int* in_sizes, int n_in, void* d_out, int out_size, void* d_ws, size_t ws_size, hipStream_t stream) {
    static int grid = 0;
    if (grid == 0) {
        if (n_in != 19 || out_size != T_ALL * DM || ws_size < WS_END) { fprintf(stderr, "kernel_launch: unexpected shapes (n_in %d out %d ws %zu)\n", n_in, out_size, ws_size); grid = -1; return; }
        int dev = 0, cus = 0, per_cu = 0;
        hipGetDevice(&dev); hipDeviceGetAttribute(&cus, hipDeviceAttributeMultiprocessorCount, dev);
        hipFuncSetAttribute((const void*)fwd, hipFuncAttributeMaxDynamicSharedMemorySize, LDS_BYTES);
        hipOccupancyMaxActiveBlocksPerMultiprocessor(&per_cu, (const void*)fwd, 512, LDS_BYTES);
        if (per_cu < 1) { fprintf(stderr, "kernel_launch: occupancy query reports %d blocks per CU\n", per_cu); grid = -1; return; }
        grid = cus;
        if (grid & 1) grid -= 1;
    }
    if (grid < 0) return;
    Args a{};
    for (int i = 0; i < 19; ++i) a.in[i] = (const float*)d_in[i];
    a.out = (float*)d_out; a.ws = (unsigned char*)d_ws;
#if ONE_LAUNCH
    a.ph_lo = 0; a.ph_hi = N_PHASES;
    if (hipMemsetAsync((char*)d_ws + OFF_BAR, 0, XCD_BAR_WORDS_C * 4, stream) != hipSuccess) { fprintf(stderr, "kernel_launch: memset of the barrier words failed\n"); return; }
    void* args[] = {&a};
    hipError_t e = hipLaunchCooperativeKernel((const void*)fwd, dim3(grid), dim3(512), args, LDS_BYTES, stream);
    if (e != hipSuccess) fprintf(stderr, "cooperative launch failed: %s (grid %d)\n", hipGetErrorString(e), grid);
#else
    for (int ph = 0; ph < N_PHASES; ++ph) { a.ph_lo = ph; a.ph_hi = ph + 1; hipLaunchKernelGGL(fwd, dim3(grid), dim3(512), LDS_BYTES, stream, a); }
#endif
}
```
